# Optimizing an MI355X kernel written in HIP

```python
import math
import jax, jax.numpy as jnp
from jax import lax
import numpy as np

D_MODEL = 2048
BATCH = 4
SEQ = 4096
DEPTH = 1

MIX_WIDTH = D_MODEL
ATTN_WIDTH = MIX_WIDTH // 2
SSM_WIDTH = MIX_WIDTH - ATTN_WIDTH
HEAD_DIM = 128
N_HEADS = ATTN_WIDTH // HEAD_DIM
DILATED_PATTERNS = ((128, 1), (512, 4), (2048, 16))
N_BUCKETS = 32
MAX_DISTANCE = 2048
SSM_GROUP = 16
N_SSM_GROUPS = SSM_WIDTH // SSM_GROUP
SSM_STATE = 64
D_FF = 5632
EPS = 1e-6
DT_MIN = 0.001
DT_MAX = 0.1
NEG_INF = -1e30

kernel_name = 'hybrid_dilated_attn_s5_macaron'


def rms_norm(x, g):
    xf = x.astype(jnp.float32)
    y = xf * lax.rsqrt(jnp.mean(xf * xf, axis=-1, keepdims=True) + EPS)
    return (y * g.astype(jnp.float32)).astype(x.dtype)


def swiglu_ffn(x, w_gate, w_up, w_down):
    return (jax.nn.silu(x @ w_gate) * (x @ w_up)) @ w_down


def t5_causal_bucket(dist):
    max_exact = N_BUCKETS // 2
    d_f = jnp.maximum(dist, max_exact).astype(jnp.float32)
    large = max_exact + (jnp.log(d_f / max_exact) / math.log(MAX_DISTANCE / max_exact)
                         * (N_BUCKETS - max_exact)).astype(jnp.int32)
    large = jnp.minimum(large, N_BUCKETS - 1)
    return jnp.where(dist < max_exact, dist, large)


def dilated_window_attention(q, k, v, rel_bias, window, dilation):
    bsz, seq, nh, hd = q.shape
    span = window // dilation
    block = span * dilation
    n_blk = -(-seq // block)
    length = n_blk * block
    pad = length - seq

    def to_blocks(t):
        t = jnp.pad(t, ((0, 0), (0, pad), (0, 0), (0, 0)))
        return t.reshape(bsz, n_blk, span, dilation, nh, hd)

    def with_prev(t):
        prev = jnp.pad(t[:, :-1], ((0, 0), (1, 0), (0, 0), (0, 0), (0, 0), (0, 0)))
        return jnp.concatenate([prev, t], axis=2)

    qb = to_blocks(q)
    kc = with_prev(to_blocks(k))
    vc = with_prev(to_blocks(v))
    scores = jnp.einsum('bnidhe,bnjdhe->bndhij', qb, kc,
                        preferred_element_type=jnp.float32) / math.sqrt(hd)
    qi = jnp.arange(span)[:, None]
    kj = jnp.arange(2 * span)[None, :]
    delta = qi + span - kj
    bucket = t5_causal_bucket(jnp.maximum(delta, 0) * dilation)
    bias = jnp.transpose(rel_bias[bucket].astype(jnp.float32), (2, 0, 1))
    blk_idx = jnp.arange(n_blk)[:, None, None]
    valid = (delta >= 0) & (delta <= span) & ((blk_idx > 0) | (kj >= span))
    logits = scores + bias[None, None, None]
    logits = jnp.where(valid[None, :, None, None], logits, NEG_INF)
    m = jnp.max(logits, axis=-1)
    p = jnp.exp(logits - m[..., None])
    s = jnp.sum(p, axis=-1)
    o = jnp.einsum('bndhij,bnjdhe->bnidhe', p.astype(vc.dtype), vc,
                   preferred_element_type=jnp.float32)
    o = o.reshape(bsz, length, nh, hd)[:, :seq]
    m = jnp.transpose(m, (0, 1, 4, 2, 3)).reshape(bsz, length, nh)[:, :seq]
    s = jnp.transpose(s, (0, 1, 4, 2, 3)).reshape(bsz, length, nh)[:, :seq]
    return o, m, s


def mixture_of_dilations(q, k, v, rel_bias):
    results = [dilated_window_attention(q, k, v, rel_bias, w, d) for (w, d) in DILATED_PATTERNS]
    m_all = jnp.stack([r[1] for r in results], axis=0)
    m_max = jnp.max(m_all, axis=0)
    num = 0.0
    den = 0.0
    for (o, m, s) in results:
        w = jnp.exp(m - m_max)
        num = num + w[..., None] * o
        den = den + w * s
    return num / den[..., None]


def complex_affine_combine(e1, e2):
    ar1, ai1, br1, bi1 = e1
    ar2, ai2, br2, bi2 = e2
    ar = ar2 * ar1 - ai2 * ai1
    ai = ar2 * ai1 + ai2 * ar1
    br = ar2 * br1 - ai2 * bi1 + br2
    bi = ar2 * bi1 + ai2 * br1 + bi2
    return (ar, ai, br, bi)


def s5_ssm(u, lambda_re, lambda_im, log_dt, b_re, b_im, c_re, c_im, d_skip):
    bsz, seq, _ = u.shape
    ug = u.astype(jnp.float32).reshape(bsz, seq, N_SSM_GROUPS, SSM_GROUP)
    dt = jnp.exp(log_dt.astype(jnp.float32))[:, None]
    lr = lambda_re.astype(jnp.float32)
    li = lambda_im.astype(jnp.float32)
    mag = jnp.exp(lr * dt)
    a_re = mag * jnp.cos(li * dt)
    a_im = mag * jnp.sin(li * dt)
    zr = a_re - 1.0
    zi = a_im
    lam_sq = lr * lr + li * li
    coef_re = (zr * lr + zi * li) / lam_sq
    coef_im = (zi * lr - zr * li) / lam_sq
    br = b_re.astype(jnp.float32)
    bim = b_im.astype(jnp.float32)
    bbar_re = coef_re[..., None] * br - coef_im[..., None] * bim
    bbar_im = coef_re[..., None] * bim + coef_im[..., None] * br
    bu_re = jnp.einsum('gpc,bsgc->bsgp', bbar_re, ug)
    bu_im = jnp.einsum('gpc,bsgc->bsgp', bbar_im, ug)
    a_re_b = jnp.broadcast_to(a_re, bu_re.shape)
    a_im_b = jnp.broadcast_to(a_im, bu_im.shape)
    _, _, x_re, x_im = lax.associative_scan(complex_affine_combine,
                                            (a_re_b, a_im_b, bu_re, bu_im), axis=1)
    y = (jnp.einsum('gcp,bsgp->bsgc', c_re.astype(jnp.float32), x_re)
         - jnp.einsum('gcp,bsgp->bsgc', c_im.astype(jnp.float32), x_im)
         + d_skip.astype(jnp.float32).reshape(N_SSM_GROUPS, SSM_GROUP) * ug)
    return y.reshape(bsz, seq, SSM_WIDTH)


def setup_inputs(seed: int = 0) -> dict:
    key = jax.random.key(seed)
    ks = jax.random.split(key, 26)
    f32 = jnp.float32

    def nrm(k, shape, scale):
        return jax.random.normal(k, shape, f32) * scale

    def gain(k, shape):
        return 1.0 + 0.01 * jax.random.normal(k, shape, f32)

    L = DEPTH
    x = jax.random.normal(ks[0], (BATCH, SEQ, D_MODEL), f32)
    ffn1_norm = gain(ks[1], (L, D_MODEL))
    ffn1_w_gate = nrm(ks[2], (L, D_MODEL, D_FF), D_MODEL ** -0.5)
    ffn1_w_up = nrm(ks[3], (L, D_MODEL, D_FF), D_MODEL ** -0.5)
    ffn1_w_down = nrm(ks[4], (L, D_FF, D_MODEL), D_FF ** -0.5)
    mix_norm = gain(ks[5], (L, D_MODEL))
    w_in = nrm(ks[6], (L, D_MODEL, 3 * ATTN_WIDTH + SSM_WIDTH), D_MODEL ** -0.5)
    q_norm = gain(ks[7], (L, HEAD_DIM))
    k_norm = gain(ks[8], (L, HEAD_DIM))
    rel_bias = nrm(ks[9], (N_BUCKETS, N_HEADS), 0.1)
    n_idx = jnp.arange(SSM_STATE, dtype=f32)
    ssm_lambda_re = -0.5 + 0.01 * jax.random.normal(ks[10], (L, N_SSM_GROUPS, SSM_STATE), f32)
    ssm_lambda_im = math.pi * n_idx + 0.01 * jax.random.normal(ks[11], (L, N_SSM_GROUPS, SSM_STATE), f32)
    ssm_log_dt = jax.random.uniform(ks[12], (L, N_SSM_GROUPS), f32,
                                    minval=math.log(DT_MIN), maxval=math.log(DT_MAX))
    ssm_b_re = nrm(ks[13], (L, N_SSM_GROUPS, SSM_STATE, SSM_GROUP), (2 * SSM_GROUP) ** -0.5)
    ssm_b_im = nrm(ks[14], (L, N_SSM_GROUPS, SSM_STATE, SSM_GROUP), (2 * SSM_GROUP) ** -0.5)
    ssm_c_re = nrm(ks[15], (L, N_SSM_GROUPS, SSM_GROUP, SSM_STATE), (2 * SSM_STATE) ** -0.5)
    ssm_c_im = nrm(ks[16], (L, N_SSM_GROUPS, SSM_GROUP, SSM_STATE), (2 * SSM_STATE) ** -0.5)
    ssm_d = nrm(ks[17], (L, SSM_WIDTH), 1.0)
    glu_w = nrm(ks[18], (L, SSM_WIDTH, SSM_WIDTH), SSM_WIDTH ** -0.5)
    glu_b = nrm(ks[19], (L, SSM_WIDTH), 0.01)
    w_out = nrm(ks[20], (L, MIX_WIDTH, D_MODEL), MIX_WIDTH ** -0.5)
    ffn2_norm = gain(ks[21], (L, D_MODEL))
    ffn2_w_gate = nrm(ks[22], (L, D_MODEL, D_FF), D_MODEL ** -0.5)
    ffn2_w_up = nrm(ks[23], (L, D_MODEL, D_FF), D_MODEL ** -0.5)
    ffn2_w_down = nrm(ks[24], (L, D_FF, D_MODEL), D_FF ** -0.5)
    return {'x': x, 'ffn1_norm': ffn1_norm, 'ffn1_w_gate': ffn1_w_gate, 'ffn1_w_up': ffn1_w_up,
            'ffn1_w_down': ffn1_w_down, 'mix_norm': mix_norm, 'w_in': w_in, 'q_norm': q_norm,
            'k_norm': k_norm, 'rel_bias': rel_bias, 'ssm_lambda_re': ssm_lambda_re,
            'ssm_lambda_im': ssm_lambda_im, 'ssm_log_dt': ssm_log_dt, 'ssm_b_re': ssm_b_re,
            'ssm_b_im': ssm_b_im, 'ssm_c_re': ssm_c_re, 'ssm_c_im': ssm_c_im, 'ssm_d': ssm_d,
            'glu_w': glu_w, 'glu_b': glu_b, 'w_out': w_out, 'ffn2_norm': ffn2_norm,
            'ffn2_w_gate': ffn2_w_gate, 'ffn2_w_up': ffn2_w_up, 'ffn2_w_down': ffn2_w_down}


def reference(x, ffn1_norm, ffn1_w_gate, ffn1_w_up, ffn1_w_down, mix_norm, w_in, q_norm,
              k_norm, rel_bias, ssm_lambda_re, ssm_lambda_im, ssm_log_dt, ssm_b_re, ssm_b_im,
              ssm_c_re, ssm_c_im, ssm_d, glu_w, glu_b, w_out, ffn2_norm, ffn2_w_gate,
              ffn2_w_up, ffn2_w_down):
    bsz, seq, _ = x.shape
    h = x
    for l in range(DEPTH):
        h = h + 0.5 * swiglu_ffn(rms_norm(h, ffn1_norm[l]), ffn1_w_gate[l], ffn1_w_up[l], ffn1_w_down[l])
        hn = rms_norm(h, mix_norm[l])
        proj = hn @ w_in[l]
        q = proj[..., :ATTN_WIDTH].reshape(bsz, seq, N_HEADS, HEAD_DIM)
        k = proj[..., ATTN_WIDTH:2 * ATTN_WIDTH].reshape(bsz, seq, N_HEADS, HEAD_DIM)
        v = proj[..., 2 * ATTN_WIDTH:3 * ATTN_WIDTH].reshape(bsz, seq, N_HEADS, HEAD_DIM)
        u = proj[..., 3 * ATTN_WIDTH:]
        q = rms_norm(q, q_norm[l])
        k = rms_norm(k, k_norm[l])
        attn = mixture_of_dilations(q, k, v, rel_bias).reshape(bsz, seq, ATTN_WIDTH).astype(h.dtype)
        y = s5_ssm(u, ssm_lambda_re[l], ssm_lambda_im[l], ssm_log_dt[l], ssm_b_re[l], ssm_b_im[l],
                   ssm_c_re[l], ssm_c_im[l], ssm_d[l])
        y = jax.nn.gelu(y)
        y = y * jax.nn.sigmoid(y @ glu_w[l].astype(jnp.float32) + glu_b[l].astype(jnp.float32))
        mixed = jnp.concatenate([attn, y.astype(h.dtype)], axis=-1) @ w_out[l]
        h = h + mixed
        h = h + 0.5 * swiglu_ffn(rms_norm(h, ffn2_norm[l]), ffn2_w_gate[l], ffn2_w_up[l], ffn2_w_down[l])
    return h
```

```cpp
#include <hip/hip_runtime.h>
#include <hip/hip_cooperative_groups.h>
#include <cstdio>
#include <cstdint>
#include <cmath>
namespace cg = cooperative_groups;
namespace pg8 {
#define PG8_LAS __attribute__((address_space(3)))
typedef unsigned short bf16_t;
typedef short bf16x8 __attribute__((ext_vector_type(8)));
typedef float f32x4 __attribute__((ext_vector_type(4)));
typedef unsigned u32x4 __attribute__((ext_vector_type(4)));
constexpr int BM = 256, BK = 64, HALF = 128, HTB = HALF * BK * 2  , STAGE_BYTES = 8 * HTB, NXCD = 8, WGM = 8;

__host__ __device__ __forceinline__ int lds_byte(int r, int c) { const int st = (r >> 4) * 2 + (c >> 5), rr = r & 15, cc = c & 31, ob = rr * 64 + cc * 2; return st * 1024 + (ob ^ (((ob >> 9) & 1) << 5)); }
__host__ __device__ __forceinline__ void stage_rc(int b, int& R, int& C) { const int st = b / 1024, sb = b % 1024, swz = sb ^ (((sb >> 9) & 1) << 5); R = (st >> 1) * 16 + swz / 64; C = (st & 1) * 32 + (swz % 64) / 2; }
__host__ __device__ __forceinline__ int perm32(int rho) { const int n = rho >> 4, i = rho & 15; return 8 * (i >> 2) + 4 * n + (i & 3); }

struct Unit { int pm, pn; };
struct Gemm { const bf16_t* A; const bf16_t* Bt; int M, N, K; };

struct StaticOrder {
    int nM, nN, nwg, G, c;
    __host__ __device__ void init(int M, int N, int G_, int c_) { nM = M / BM; nN = N / BM; nwg = nM * nN; G = G_; c = c_; }
    __host__ __device__ bool next(int i, Unit& u) const {
        const long L = (long)i * G + c; if (L >= nwg) return false;
        int wgid = (int)L; { const int q = nwg / NXCD, r = nwg % NXCD, xcd = wgid % NXCD, off = wgid / NXCD; wgid = (xcd < r ? xcd * (q + 1) : r * (q + 1) + (xcd - r) * q) + off; }
        const int nig = WGM * nN, gid = wgid / nig, fm = gid * WGM, gsz = (nM - fm) < WGM ? (nM - fm) : WGM;
        u.pm = fm + ((wgid % nig) % gsz); u.pn = (wgid % nig) / gsz; return true;
    }
    __device__ __forceinline__ void a_ready(const Unit&) const {}
    __device__ __forceinline__ void done(const Unit&) const {}
};

typedef float f32x2 __attribute__((ext_vector_type(2)));
typedef unsigned u32x2 __attribute__((ext_vector_type(2)));
typedef __bf16 bf16v2_t __attribute__((ext_vector_type(2)));
__device__ __forceinline__ unsigned cvt_pk_bf16(float lo, float hi) { return __builtin_bit_cast(unsigned, __builtin_convertvector((f32x2){lo, hi}, bf16v2_t)); }
__device__ __forceinline__ u32x2 pack4(f32x4 v) { u32x2 w; w.x = cvt_pk_bf16(v[0], v[1]); w.y = cvt_pk_bf16(v[2], v[3]); return w; }
__device__ __forceinline__ float fast_sigmoid(float z) { return __builtin_amdgcn_rcpf(1.0f + __builtin_amdgcn_exp2f(-1.44269504089f * z)); }
constexpr float RMS_EPS = 1e-6f;

__device__ __forceinline__ float row_ss(const float* ssp, int row, int fq, int npart) {
    if (npart == 1) return ssp[row];
    const f32x4 a = *(const f32x4*)(ssp + (size_t)row * 32 + fq * 8), b = *(const f32x4*)(ssp + (size_t)row * 32 + fq * 8 + 4);
    float s = ((a[0] + a[1]) + (a[2] + a[3])) + ((b[0] + b[1]) + (b[2] + b[3])); s += __shfl_xor(s, 16); s += __shfl_xor(s, 32); return s;
}
struct EpiGateUp {
    static constexpr bool PERM = false, AFTER_DRAIN = false;
    bf16_t* H; const float* ss; int ldh; int npart;
    __device__ __forceinline__ void operator()(const f32x4 (&acc)[2][2][4][2], const Unit& u, int wr, int wc, int fr, int fq) const {
        const int row0 = u.pm * BM + wr * 64 + fr, hc0 = u.pn * 128 + wc * 16 + 4 * fq;
        float rinv8[2][4];
#pragma unroll
        for (int ai = 0; ai < 2; ++ai)
#pragma unroll
            for (int m = 0; m < 4; ++m) rinv8[ai][m] = __builtin_amdgcn_rsqf(row_ss(ss, row0 + ai * HALF + m * 16, fq, npart) * (1.0f / 2048.0f) + RMS_EPS);
#pragma unroll
        for (int ai = 0; ai < 2; ++ai)
#pragma unroll
            for (int m = 0; m < 4; ++m) { const int row = row0 + ai * HALF + m * 16; const float rinv = rinv8[ai][m];
                bf16_t* rowp = H + (size_t)row * ldh + hc0;
#pragma unroll
                for (int bj = 0; bj < 2; ++bj) { const f32x4 g = acc[ai][bj][m][0] * rinv, up = acc[ai][bj][m][1] * rinv; f32x4 hv;
#pragma unroll
                    for (int j = 0; j < 4; ++j) hv[j] = g[j] * fast_sigmoid(g[j]) * up[j];
                    *(u32x2*)(rowp + bj * 64) = pack4(hv); } }
    }
};
struct EpiResid {
    static constexpr bool PERM = false, AFTER_DRAIN = false;
    const float* basef; const bf16_t* baseb; float* outf; bf16_t* ob; float* ssacc; float scale; int ldc;
    __device__ __forceinline__ void operator()(const f32x4 (&acc)[2][2][4][2], const Unit& u, int wr, int wc, int fr, int fq) const {
        const int row0 = u.pm * BM + wr * 64 + fr, col0 = u.pn * BM + wc * 32 + 4 * fq;
#pragma unroll
        for (int ai = 0; ai < 2; ++ai)
#pragma unroll
            for (int mp = 0; mp < 2; ++mp) {
                f32x4 bs[2][2][2];
                if (basef) {
#pragma unroll
                    for (int mm = 0; mm < 2; ++mm)
#pragma unroll
                        for (int bj = 0; bj < 2; ++bj)
#pragma unroll
                            for (int n = 0; n < 2; ++n) bs[mm][bj][n] = *(const f32x4*)(basef + (size_t)(row0 + ai * HALF + (2 * mp + mm) * 16) * ldc + col0 + bj * HALF + n * 16);
                } else { u32x2 w[2][2][2];
#pragma unroll
                    for (int mm = 0; mm < 2; ++mm)
#pragma unroll
                        for (int bj = 0; bj < 2; ++bj)
#pragma unroll
                            for (int n = 0; n < 2; ++n) w[mm][bj][n] = *(const u32x2*)(baseb + (size_t)(row0 + ai * HALF + (2 * mp + mm) * 16) * ldc + col0 + bj * HALF + n * 16);
#pragma unroll
                    for (int mm = 0; mm < 2; ++mm)
#pragma unroll
                        for (int bj = 0; bj < 2; ++bj)
#pragma unroll
                            for (int n = 0; n < 2; ++n) bs[mm][bj][n] = (f32x4){__uint_as_float(w[mm][bj][n].x << 16), __uint_as_float(w[mm][bj][n].x & 0xffff0000u), __uint_as_float(w[mm][bj][n].y << 16), __uint_as_float(w[mm][bj][n].y & 0xffff0000u)};
                }
#pragma unroll
                for (int mm = 0; mm < 2; ++mm) { const int m = 2 * mp + mm, row = row0 + ai * HALF + m * 16; const size_t off = (size_t)row * ldc + col0; float s = 0.f;
#pragma unroll
                    for (int bj = 0; bj < 2; ++bj)
#pragma unroll
                        for (int n = 0; n < 2; ++n) { const f32x4 v = bs[mm][bj][n] + acc[ai][bj][m][n] * scale;
                            if (outf) *(f32x4*)(outf + off + bj * HALF + n * 16) = v;
                            if (ob) *(u32x2*)(ob + off + bj * HALF + n * 16) = pack4(v);
                            s += (v[0] * v[0] + v[1] * v[1]) + (v[2] * v[2] + v[3] * v[3]); }
                    if (ssacc) { s += __shfl_xor(s, 16); s += __shfl_xor(s, 32); if (fq == 0) ssacc[(size_t)row * 32 + u.pn * 4 + wc] = s; } }
            }
    }
};
__device__ __forceinline__ int perm_tok(int t) { return (t & ~63) | ((t & 15) << 2) | ((t >> 4) & 3); }
struct EpiWin {
    static constexpr bool PERM = false, AFTER_DRAIN = false; static constexpr size_t SEGSTRIDE = 16u * 1024u * 1024u;
    const float* ss; bf16_t* qkvu; float* ssqk;
    __device__ __forceinline__ void operator()(const f32x4 (&acc)[2][2][4][2], const Unit& u, int wr, int wc, int fr, int fq) const {
        const int seg = u.pn >> 2, ct = (u.pn & 3) * 256;
        const int row0 = u.pm * BM + wr * 64 + fr;
        float rinv[2][4];
#pragma unroll
        for (int ai = 0; ai < 2; ++ai)
#pragma unroll
            for (int m = 0; m < 4; ++m) rinv[ai][m] = __builtin_amdgcn_rsqf(row_ss(ss, row0 + ai * HALF + m * 16, fq, 32) * (1.0f / 2048.0f) + RMS_EPS);
        if (seg == 2) {
#pragma unroll
            for (int ai = 0; ai < 2; ++ai) { const int rb = u.pm * BM + ai * HALF + wr * 64; const int b = rb >> 12, tl = rb & 4095;
#pragma unroll
                for (int bj = 0; bj < 2; ++bj) { const int head = (u.pn & 3) * 2 + bj;
#pragma unroll
                    for (int n = 0; n < 2; ++n)
#pragma unroll
                        for (int j = 0; j < 4; ++j) { const int dim = wc * 32 + n * 16 + 4 * fq + j;
                            const f32x4 v = (f32x4){acc[ai][bj][0][n][j] * rinv[ai][0], acc[ai][bj][1][n][j] * rinv[ai][1], acc[ai][bj][2][n][j] * rinv[ai][2], acc[ai][bj][3][n][j] * rinv[ai][3]};
                            *(u32x2*)(qkvu + 2 * SEGSTRIDE + ((((size_t)((b * 8 + head) * 8 + (wc * 2 + n)) * 1024 + 16 * (tl >> 6) + fr) * 16 + 4 * fq + j) * 4)) = pack4(v); } } }
            return;
        }
        if (seg == 3) {
#pragma unroll
            for (int ai = 0; ai < 2; ++ai)
#pragma unroll
                for (int m = 0; m < 4; ++m) { const int row = row0 + ai * HALF + m * 16; const int b = row >> 12, t = row & 4095;
#pragma unroll
                    for (int bj = 0; bj < 2; ++bj)
#pragma unroll
                        for (int n = 0; n < 2; ++n) { const int grp = 16 * (u.pn & 3) + 8 * bj + 2 * wc + n;
                            *(u32x2*)(qkvu + 3 * SEGSTRIDE + ((size_t)(b * 64 + grp) * 4096 + t) * 16 + 4 * fq) = pack4(acc[ai][bj][m][n] * rinv[ai][m]); } }
            return;
        }
        bf16_t* dst = qkvu + (size_t)seg * SEGSTRIDE;
#pragma unroll
        for (int ai = 0; ai < 2; ++ai)
#pragma unroll
            for (int m = 0; m < 4; ++m) { const int row = row0 + ai * HALF + m * 16; bf16_t* rowp = dst + (size_t)row * 1024 + ct + wc * 32 + 4 * fq;
#pragma unroll
                for (int bj = 0; bj < 2; ++bj) { float s = 0.f;
#pragma unroll
                    for (int n = 0; n < 2; ++n) { const f32x4 v = acc[ai][bj][m][n] * rinv[ai][m]; *(u32x2*)(rowp + bj * HALF + n * 16) = pack4(v);
                        s += (v[0] * v[0] + v[1] * v[1]) + (v[2] * v[2] + v[3] * v[3]); }
                    if (seg < 2) { s += __shfl_xor(s, 16); s += __shfl_xor(s, 32);
                        if (fq == 0) ssqk[((size_t)(seg * 8 + (u.pn & 3) * 2 + bj) * 16384 + perm_tok(row)) * 4 + wc] = s; } } }
    }
};
struct EpiGlu {
    static constexpr bool PERM = false, AFTER_DRAIN = false;
    const bf16_t* yg; const float* bias; bf16_t* mixed;
    __device__ __forceinline__ void operator()(const f32x4 (&acc)[2][2][4][2], const Unit& u, int wr, int wc, int fr, int fq) const {
        const int row0 = u.pm * BM + wr * 64 + fr, col0 = u.pn * BM + wc * 32 + 4 * fq;
        f32x4 bv[2][2];
#pragma unroll
        for (int bj = 0; bj < 2; ++bj)
#pragma unroll
            for (int n = 0; n < 2; ++n) bv[bj][n] = *(const f32x4*)(bias + col0 + bj * HALF + n * 16);
#pragma unroll
        for (int ai = 0; ai < 2; ++ai) { u32x2 yw[4][2][2];
#pragma unroll
            for (int m = 0; m < 4; ++m)
#pragma unroll
                for (int bj = 0; bj < 2; ++bj)
#pragma unroll
                    for (int n = 0; n < 2; ++n) yw[m][bj][n] = *(const u32x2*)(yg + (size_t)(row0 + ai * HALF + m * 16) * 1024 + col0 + bj * HALF + n * 16);
#pragma unroll
            for (int m = 0; m < 4; ++m) { const int row = row0 + ai * HALF + m * 16;
#pragma unroll
                for (int bj = 0; bj < 2; ++bj)
#pragma unroll
                    for (int n = 0; n < 2; ++n) { const int col = col0 + bj * HALF + n * 16; const u32x2 w = yw[m][bj][n];
                        const f32x4 z = acc[ai][bj][m][n] + bv[bj][n]; f32x4 y, o;
                        y[0] = __uint_as_float(w.x << 16); y[1] = __uint_as_float(w.x & 0xffff0000u); y[2] = __uint_as_float(w.y << 16); y[3] = __uint_as_float(w.y & 0xffff0000u);
#pragma unroll
                        for (int j = 0; j < 4; ++j) o[j] = y[j] * fast_sigmoid(z[j]);
                        *(u32x2*)(mixed + (size_t)row * 2048 + 1024 + col) = pack4(o); } } }
    }
};
template <class Epi, class Sched, bool ALIGN_EPI = false, bool SP2 = false>
__device__ __forceinline__ void gemm_phase(PG8_LAS unsigned char* lds, const Gemm g, const Sched& S, const Epi& E) {
    const int tid = threadIdx.x, wid = __builtin_amdgcn_readfirstlane(tid >> 6), lane = tid & 63, wr = wid >> 2, wc = wid & 3, fr = lane & 15, fq = lane >> 4;
    const int K = g.K, nt = K / BK;
    unsigned voffA[2], voffB[2];
#pragma unroll
    for (int i = 0; i < 2; ++i) { int R, C; stage_rc(tid * 16 + i * 8192, R, C); const int Rb = Epi::PERM ? ((R & ~31) + perm32(R & 31)) : R;
        voffA[i] = (unsigned)(R * K + C) * 2u; voffB[i] = (unsigned)(Rb * K + C) * 2u; }
    const size_t kstep = (size_t)(BK * 2);
    const size_t hstep = (size_t)HALF * K * 2;
    const size_t tstep = 2 * hstep;
    const unsigned ldsw = (unsigned)wid * 1024u;
    const int aoff = lds_byte(wr * 64 + fr, fq * 8), boff = lds_byte(wc * 32 + fr, fq * 8);
#define PG8_SA(b, h) (((b) * 2 + (h)) * HTB)
#define PG8_SB(b, h) ((4 + (b) * 2 + (h)) * HTB)
#define PG8_STAGE(bufoff, gbase, voff) do { _Pragma("unroll") for (int _i = 0; _i < 2; ++_i) \
        __builtin_amdgcn_global_load_lds((const unsigned*)((const char*)(gbase) + (voff)[_i]), (PG8_LAS unsigned*)(lds + (bufoff) + ldsw + _i * 8192), 16, 0, 0); } while (0)
#define PG8_LDA(dst, b, h) do { _Pragma("unroll") for (int m = 0; m < 4; ++m) _Pragma("unroll") for (int k = 0; k < 2; ++k) dst[m][k] = *(const PG8_LAS bf16x8*)(lds + PG8_SA(b, h) + aoff + m * 2048 + k * 1024); } while (0)
#define PG8_LDB(dst, b, h) do { _Pragma("unroll") for (int n = 0; n < 2; ++n) _Pragma("unroll") for (int k = 0; k < 2; ++k) dst[n][k] = *(const PG8_LAS bf16x8*)(lds + PG8_SB(b, h) + boff + n * 2048 + k * 1024); } while (0)
#define PG8_MMA(ai, bj, At, Bt) do { __builtin_amdgcn_s_setprio(1); _Pragma("unroll") for (int m = 0; m < 4; ++m) _Pragma("unroll") for (int n = 0; n < 2; ++n) _Pragma("unroll") for (int k = 0; k < 2; ++k) \
        acc[ai][bj][m][n] = __builtin_amdgcn_mfma_f32_16x16x32_bf16(Bt[n][k], At[m][k], acc[ai][bj][m][n], 0, 0, 0); __builtin_amdgcn_s_setprio(0); } while (0)
#define PG8_WAIT_V(n) asm volatile("s_waitcnt vmcnt(" #n ")" ::: "memory")
#define PG8_WAIT_L(n) asm volatile("s_waitcnt lgkmcnt(" #n ")" ::: "memory")
#define PG8_BAR __builtin_amdgcn_s_barrier()
#define PG8_SCHED __builtin_amdgcn_sched_barrier(0)
    Unit cur, nxt; int ui = 0;
    if (!S.next(0, cur)) return;
    f32x4 acc[2][2][4][2];
#pragma unroll
    for (int a = 0; a < 2; ++a)
#pragma unroll
        for (int b = 0; b < 2; ++b)
#pragma unroll
            for (int m = 0; m < 4; ++m)
#pragma unroll
                for (int n = 0; n < 2; ++n) acc[a][b][m][n] = (f32x4){0.f, 0.f, 0.f, 0.f};
    bf16x8 At[4][2], B0[2][2], B1[2][2];
    const char* cA = (const char*)g.A + (size_t)cur.pm * tstep; const char* cB = (const char*)g.Bt + (size_t)cur.pn * tstep;
    S.a_ready(cur);
    if constexpr (SP2) {
        PG8_STAGE(PG8_SB(0, 0), cB, voffB); PG8_STAGE(PG8_SB(0, 1), cB + hstep, voffB); PG8_STAGE(PG8_SA(0, 0), cA, voffA); PG8_STAGE(PG8_SA(0, 1), cA + hstep, voffA);
        if (wr == 1) PG8_BAR;
        PG8_WAIT_V(2); PG8_BAR;
        PG8_STAGE(PG8_SB(1, 0), cB + kstep, voffB); PG8_STAGE(PG8_SA(1, 0), cA + kstep, voffA); PG8_STAGE(PG8_SB(1, 1), cB + hstep + kstep, voffB);
        PG8_WAIT_V(6); PG8_BAR;
    } else {
        PG8_STAGE(PG8_SB(0, 0), cB, voffB); PG8_STAGE(PG8_SA(0, 0), cA, voffA); PG8_STAGE(PG8_SB(0, 1), cB + hstep, voffB); PG8_STAGE(PG8_SA(0, 1), cA + hstep, voffA);
        if (wr == 1) PG8_BAR;
        PG8_WAIT_V(4); PG8_BAR;
        PG8_STAGE(PG8_SB(1, 0), cB + kstep, voffB); PG8_STAGE(PG8_SA(1, 0), cA + kstep, voffA); PG8_STAGE(PG8_SB(1, 1), cB + hstep + kstep, voffB);
        PG8_WAIT_V(6); PG8_BAR;
    }
    for (;;) {
        const bool has_next = S.next(ui + 1, nxt);
        const char* nA = has_next ? (const char*)g.A + (size_t)nxt.pm * tstep : cA; const char* nB = has_next ? (const char*)g.Bt + (size_t)nxt.pn * tstep : cB;
        for (int t = 0; t < nt; t += 2) {
            const bool last = (t == nt - 2);
            const char* a1 = cA + (size_t)(t + 1) * kstep;
            const char* a2 = last ? nA : cA + (size_t)(t + 2) * kstep; const char* b2 = last ? nB : cB + (size_t)(t + 2) * kstep;
            const char* a3 = a2 + kstep; const char* b3 = b2 + kstep;
            if (last && has_next) S.a_ready(nxt);
            if constexpr (SP2) {
            PG8_LDB(B0, 0, 0); PG8_LDB(B1, 0, 1); PG8_SCHED; PG8_LDA(At, 0, 0); PG8_STAGE(PG8_SA(1, 1), a1 + hstep, voffA);
            PG8_WAIT_V(8); PG8_WAIT_L(0); PG8_BAR; PG8_MMA(0, 0, At, B0); PG8_MMA(0, 1, At, B1); PG8_BAR; PG8_SCHED;
            PG8_LDA(At, 0, 1); PG8_STAGE(PG8_SB(0, 0), b2, voffB); PG8_STAGE(PG8_SB(0, 1), b2 + hstep, voffB); PG8_STAGE(PG8_SA(0, 0), a2, voffA);
            PG8_WAIT_V(8); PG8_WAIT_L(0); PG8_BAR; PG8_MMA(1, 0, At, B0); PG8_MMA(1, 1, At, B1); PG8_BAR; PG8_SCHED;
            PG8_LDB(B0, 1, 0); PG8_LDB(B1, 1, 1); PG8_SCHED; PG8_LDA(At, 1, 0); PG8_STAGE(PG8_SA(0, 1), a2 + hstep, voffA);
            PG8_WAIT_V(8); PG8_WAIT_L(0); PG8_BAR; PG8_MMA(0, 0, At, B0); PG8_MMA(0, 1, At, B1); PG8_BAR; PG8_SCHED;
            PG8_LDA(At, 1, 1); PG8_STAGE(PG8_SB(1, 0), b3, voffB); PG8_STAGE(PG8_SB(1, 1), b3 + hstep, voffB); PG8_STAGE(PG8_SA(1, 0), a3, voffA);
            PG8_WAIT_V(8); PG8_WAIT_L(0); PG8_BAR; PG8_MMA(1, 0, At, B0); PG8_MMA(1, 1, At, B1); PG8_BAR; PG8_SCHED;
            } else {
            PG8_LDB(B0, 0, 0); PG8_SCHED; PG8_LDA(At, 0, 0); PG8_STAGE(PG8_SA(1, 1), a1 + hstep, voffA);
            PG8_WAIT_L(8); PG8_BAR; PG8_WAIT_L(0); PG8_MMA(0, 0, At, B0); PG8_BAR; PG8_SCHED;
            PG8_LDB(B1, 0, 1); PG8_STAGE(PG8_SB(0, 0), b2, voffB);
            PG8_BAR; PG8_WAIT_L(0); PG8_MMA(0, 1, At, B1); PG8_BAR;
            PG8_LDA(At, 0, 1); PG8_STAGE(PG8_SA(0, 0), a2, voffA);
            PG8_BAR; PG8_WAIT_L(0); PG8_MMA(1, 0, At, B0); PG8_BAR; PG8_SCHED;
            PG8_STAGE(PG8_SB(0, 1), b2 + hstep, voffB);
            PG8_WAIT_V(6); PG8_BAR; PG8_MMA(1, 1, At, B1); PG8_BAR;
            PG8_LDB(B0, 1, 0); PG8_SCHED; PG8_LDA(At, 1, 0); PG8_STAGE(PG8_SA(0, 1), a2 + hstep, voffA);
            PG8_WAIT_L(8); PG8_BAR; PG8_WAIT_L(0); PG8_MMA(0, 0, At, B0); PG8_BAR; PG8_SCHED;
            PG8_LDB(B1, 1, 1); PG8_STAGE(PG8_SB(1, 0), b3, voffB);
            PG8_BAR; PG8_WAIT_L(0); PG8_MMA(0, 1, At, B1); PG8_BAR;
            PG8_LDA(At, 1, 1); PG8_STAGE(PG8_SA(1, 0), a3, voffA);
            PG8_BAR; PG8_WAIT_L(0); PG8_MMA(1, 0, At, B0); PG8_BAR; PG8_SCHED;
            PG8_STAGE(PG8_SB(1, 1), b3 + hstep, voffB);
            PG8_WAIT_V(6); PG8_BAR; PG8_MMA(1, 1, At, B1); PG8_BAR;
            }
        }
        if constexpr (ALIGN_EPI) { if (wr == 0) PG8_BAR; }
        if constexpr (!Epi::AFTER_DRAIN) { E(acc, cur, wr, wc, fr, fq); S.done(cur); }
        if (!has_next) break;
#pragma unroll
        for (int a = 0; a < 2; ++a)
#pragma unroll
            for (int b = 0; b < 2; ++b)
#pragma unroll
                for (int m = 0; m < 4; ++m)
#pragma unroll
                    for (int n = 0; n < 2; ++n) acc[a][b][m][n] = (f32x4){0.f, 0.f, 0.f, 0.f};
        cur = nxt; cA = nA; cB = nB; ++ui;
        if constexpr (ALIGN_EPI) { if (wr == 1) PG8_BAR; }
    }
    PG8_WAIT_V(0);
    if constexpr (!ALIGN_EPI) { if (wr == 0) PG8_BAR; }
    PG8_BAR;
    if constexpr (Epi::AFTER_DRAIN) { E.fused(acc, cur, wr, wc, fr, fq, lds, wid, lane); S.done(cur); }
#undef PG8_SA
#undef PG8_SB
#undef PG8_STAGE
#undef PG8_LDA
#undef PG8_LDB
#undef PG8_MMA
#undef PG8_WAIT_V
#undef PG8_WAIT_L
#undef PG8_BAR
#undef PG8_SCHED
}
}

#define LAS __attribute__((address_space(3)))
typedef unsigned short bf16_t;
typedef short bf16x8 __attribute__((ext_vector_type(8)));
typedef float f32x4 __attribute__((ext_vector_type(4)));
typedef float f32x2 __attribute__((ext_vector_type(2)));
typedef unsigned u32x4 __attribute__((ext_vector_type(4)));
typedef unsigned u32x2 __attribute__((ext_vector_type(2)));
using pg8::cvt_pk_bf16; using pg8::pack4; using pg8::perm_tok;

constexpr int M = 16384, D = 2048, FF = 5632, NIN = 4096, SEQ = 4096;
constexpr size_t MiB = 1u << 20;
constexpr size_t WS_SS0 = 402 * MiB, WS_SS1 = 403 * MiB, WS_SS2 = 405 * MiB, WS_SSQK = 407 * MiB;
constexpr size_t WS_WGU1 = 4 * MiB, WS_WD1 = 48 * MiB, WS_WIN = 70 * MiB, WS_WGLU = 86 * MiB, WS_WOUT = 88 * MiB, WS_WGU2 = 96 * MiB, WS_WD2 = 140 * MiB;
constexpr size_t WS_H2B = 4 * MiB;
constexpr size_t WS_R1 = 162 * MiB;
constexpr size_t WS_H = 226 * MiB;
constexpr size_t WS_Q = 226 * MiB, WS_K = 258 * MiB, WS_VT = 290 * MiB, WS_U = 322 * MiB, WS_YG = 354 * MiB, WS_XT = 386 * MiB;
constexpr size_t WS_BAR = 411 * MiB, WS_MIX = 412 * MiB, WS_END = 476 * MiB;
static_assert(WS_K - WS_Q == 32 * MiB && WS_VT - WS_Q == 64 * MiB && WS_U - WS_Q == 96 * MiB, "q|k|vT|u spacing");
constexpr int LDS_BYTES = 147456;

struct Params { const float* in[25]; float* out; unsigned char* ws; unsigned char bucket[3][136]; int ph_lo, ph_hi; };
#ifndef DBG_REPS
#define DBG_REPS 1
#endif
#ifndef DBG_REP4
#define DBG_REP4 1
#endif
#ifndef DBG_LAST
#define DBG_LAST 9
#define DBG_SUB 0
#define DBG_NOQ 0
#define DBG_NOK 0
#endif
#ifdef MK_SANITIZE
constexpr int NPH = 10;
#else
constexpr int NPH = 9;
#endif
#ifndef MK_N_LAUNCHES
#define MK_N_LAUNCHES 1
#endif

__device__ __forceinline__ float wave_sum(float v) {
#pragma unroll
    for (int o = 1; o < 64; o <<= 1) v += __shfl_xor(v, o);
    return v;
}
__device__ __forceinline__ float bf_lo(unsigned w) { return __uint_as_float(w << 16); }
__device__ __forceinline__ float bf_hi(unsigned w) { return __uint_as_float(w & 0xffff0000u); }

template <int MODE>
__device__ __forceinline__ void transpose_item(const float* __restrict__ W, const float* __restrict__ gain, int K, int N, bf16_t* WT, LAS float* scr, int item, int lane) {
    const int nblk = N / 32, kb = item / nblk, nb = item % nblk, k0 = 64 * kb, n0 = 32 * nb;
    float wv[32];
#pragma unroll
    for (int i = 0; i < 32; ++i) wv[i] = __builtin_nontemporal_load(W + (size_t)(k0 + 2 * i + (lane >> 5)) * N + n0 + (lane & 31));
    if (gain) {
#pragma unroll
        for (int i = 0; i < 32; ++i) wv[i] *= gain[k0 + 2 * i + (lane >> 5)]; }
#pragma unroll
    for (int i = 0; i < 32; ++i) scr[(2 * i + (lane >> 5)) * 33 + (lane & 31)] = wv[i];
    asm volatile("s_waitcnt lgkmcnt(0)" ::: "memory");
    const int c = lane & 7;
#pragma unroll
    for (int j = 0; j < 4; ++j) { const int n = (lane >> 3) + 8 * j; const LAS float* s = scr + (8 * c) * 33 + n;
        u32x4 o; o.x = cvt_pk_bf16(s[0 * 33], s[1 * 33]); o.y = cvt_pk_bf16(s[2 * 33], s[3 * 33]); o.z = cvt_pk_bf16(s[4 * 33], s[5 * 33]); o.w = cvt_pk_bf16(s[6 * 33], s[7 * 33]);
        const int ng = n0 + n; const int row = MODE == 0 ? ng : (32 * (ng >> 4) + (MODE == 2 ? 16 : 0) + (ng & 15));
        *(u32x4*)(WT + (size_t)row * K + k0 + 8 * c) = o; }
    asm volatile("s_waitcnt lgkmcnt(0)" ::: "memory");
}

__device__ __forceinline__ void sincos_d(double th, double& sn, double& cs) {
    const double k = rint(th * 0.63661977236758134308);
    double r = fma(-k, 1.57079632679489655800e+00, th); r = fma(-k, 6.12323399573676603587e-17, r);
    const long long q = (long long)k;
    const double r2 = r * r;
    double sp = -7.6471637318198164759e-13; sp = fma(sp, r2, 1.6059043836821614599e-10); sp = fma(sp, r2, -2.5052108385441718775e-08); sp = fma(sp, r2, 2.7557319223985890653e-06);
    sp = fma(sp, r2, -1.9841269841269841270e-04); sp = fma(sp, r2, 8.3333333333333333333e-03); sp = fma(sp, r2, -1.6666666666666666667e-01); const double s = fma(sp * r2, r, r);
    double cp = 4.7794773323873852974e-14; cp = fma(cp, r2, -1.1470745597729724714e-11); cp = fma(cp, r2, 2.0876756987868098979e-09); cp = fma(cp, r2, -2.7557319223985890653e-07);
    cp = fma(cp, r2, 2.4801587301587301587e-05); cp = fma(cp, r2, -1.3888888888888888889e-03); cp = fma(cp, r2, 4.1666666666666666667e-02); cp = fma(cp, r2, -0.5); const double c = fma(cp, r2, 1.0);
    const int qq = (int)(q & 3);
    sn = (qq == 0) ? s : (qq == 1) ? c : (qq == 2) ? -s : -c;
    cs = (qq == 0) ? c : (qq == 1) ? -s : (qq == 2) ? -c : s;
}
__device__ __forceinline__ double exp_d(double x) {
    const double k = rint(x * 1.44269504088896340736);
    double r = fma(-k, 6.93147180369123816490e-01, x); r = fma(-k, 1.90821492927058770002e-10, r);
    double p = 1.0 / 6227020800.0; p = fma(p, r, 1.0 / 479001600.0); p = fma(p, r, 1.0 / 39916800.0); p = fma(p, r, 1.0 / 3628800.0); p = fma(p, r, 1.0 / 362880.0); p = fma(p, r, 1.0 / 40320.0);
    p = fma(p, r, 1.0 / 5040.0); p = fma(p, r, 1.0 / 720.0); p = fma(p, r, 1.0 / 120.0); p = fma(p, r, 1.0 / 24.0); p = fma(p, r, 1.0 / 6.0); p = fma(p, r, 0.5); p = fma(p, r, 1.0); p = fma(p, r, 1.0);
    const long long e = (long long)k + 1023; const double sc = __longlong_as_double(e << 52);
    return p * sc;
}

__device__ __forceinline__ f32x2 cmul(f32x2 a, f32x2 b) { return (f32x2){a.x * b.x - a.y * b.y, a.x * b.y + a.y * b.x}; }
__device__ __forceinline__ float gelu_tanh(float x) { const float z = 0.7978845608f * (x + 0.044715f * x * x * x); return x * __builtin_amdgcn_rcpf(1.0f + __builtin_amdgcn_exp2f(-2.88539008178f * z)); }

constexpr int L_PW = 0, L_APW = 8704, L_BB = 17408, L_CC = 25600, L_KT = 33920, L_BIAS = 49152, L_MAXB = 49152 + 36864, L_RK = 90112, L_U = 42624, L_X = 42624 + 67584;
__device__ __forceinline__ void ssm_item(const Params& P, LAS unsigned char* lds, int item, int tid, int wave, int lane) {
    const int b = item >> 6, grp = item & 63;
    LAS f32x2* PW = (LAS f32x2*)(lds + L_PW); LAS f32x2* APW = (LAS f32x2*)(lds + L_APW); LAS f32x2* BB = (LAS f32x2*)(lds + L_BB); LAS f32x2* CC = (LAS f32x2*)(lds + L_CC);
    LAS bf16_t* KT = (LAS bf16_t*)(lds + L_KT);
    const bf16_t* ug = (const bf16_t*)(P.ws + WS_U); bf16_t* yg = (bf16_t*)(P.ws + WS_YG);
    float ccr[2], cci[2];
#pragma unroll
    for (int it = 0; it < 2; ++it) { ccr[it] = P.in[15][(size_t)grp * 1024 + tid + 512 * it]; cci[it] = P.in[16][(size_t)grp * 1024 + tid + 512 * it]; }
    __syncthreads();
#pragma unroll
    for (int it = 0; it < 2; ++it) { const int idx = tid + 512 * it; CC[(idx >> 6) * 65 + (idx & 63)] = (f32x2){ccr[it], cci[it]}; }
    if (tid < 64) {
        const int p = tid;
        const float lr_f = P.in[10][grp * 64 + p], li_f = P.in[11][grp * 64 + p], ldt_f = P.in[12][grp];
        f32x4 brv[4], biv[4];
#pragma unroll
        for (int c = 0; c < 4; ++c) { brv[c] = *(const f32x4*)(P.in[13] + (size_t)(grp * 64 + p) * 16 + 4 * c); biv[c] = *(const f32x4*)(P.in[14] + (size_t)(grp * 64 + p) * 16 + 4 * c); }
        __builtin_amdgcn_sched_barrier(0);
        const double lr = (double)lr_f, li = (double)li_f, dt = exp_d((double)ldt_f);
        const double mag = exp_d(lr * dt); double sn, cs; sincos_d(li * dt, sn, cs);
        const double ar = mag * cs, ai = mag * sn, zr = ar - 1.0, zi = ai, den = lr * lr + li * li;
        const double cr = (zr * lr + zi * li) / den, ci = (zi * lr - zr * li) / den;
        double pr = 1.0, pi = 0.0, alr = 1.0, ali = 0.0;
        for (int e = 0; e <= 16; ++e) { PW[e * 64 + p] = (f32x2){(float)pr, (float)pi}; if (e == 16) { alr = pr; ali = pi; } const double nr = pr * ar - pi * ai, ni = pr * ai + pi * ar; pr = nr; pi = ni; }
        pr = 1.0; pi = 0.0;
        for (int e = 0; e <= 16; ++e) { APW[e * 64 + p] = (f32x2){(float)pr, (float)pi}; const double nr = pr * alr - pi * ali, ni = pr * ali + pi * alr; pr = nr; pi = ni; }
#pragma unroll
        for (int c = 0; c < 16; ++c) { const double br = brv[c >> 2][c & 3], bi = biv[c >> 2][c & 3]; BB[p * 16 + c] = (f32x2){(float)(cr * br - ci * bi), (float)(cr * bi + ci * br)}; }
    }
    __syncthreads();
    {
        const int k = tid >> 5, co = (tid >> 1) & 15, ch = tid & 1; float acc[8];
#pragma unroll
        for (int c = 0; c < 8; ++c) acc[c] = 0.f;
        for (int p = 0; p < 64; p += 2) {
            f32x2 bb[2][8], cc[2], pw[2];
#pragma unroll
            for (int q = 0; q < 2; ++q) { cc[q] = CC[co * 65 + p + q]; pw[q] = PW[k * 64 + p + q];
#pragma unroll
                for (int c = 0; c < 8; ++c) bb[q][c] = BB[(p + q) * 16 + 8 * ch + c]; }
            __builtin_amdgcn_sched_barrier(0);
#pragma unroll
            for (int q = 0; q < 2; ++q) { const f32x2 w = cmul(cc[q], pw[q]);
#pragma unroll
                for (int c = 0; c < 8; ++c) acc[c] += w.x * bb[q][c].x - w.y * bb[q][c].y; }
        }
        const float dv = (k == 0) ? P.in[17][grp * 16 + co] : 0.f;
        unsigned pk[4];
#pragma unroll
        for (int c = 0; c < 8; c += 2) { const float v0 = acc[c] + ((8 * ch + c == co) ? dv : 0.f), v1 = acc[c + 1] + ((8 * ch + c + 1 == co) ? dv : 0.f); pk[c >> 1] = cvt_pk_bf16(v0, v1); }
        *(LAS u32x4*)(KT + (k + 1) * 256 + co * 16 + 8 * ch) = (u32x4){pk[0], pk[1], pk[2], pk[3]};
        if (tid < 128) *(LAS unsigned*)(KT + 2 * tid) = 0u;
    }
    const int n16 = lane & 15, g = lane >> 4, h8 = (g & 1) * 8;
    LAS unsigned char* UL = lds + L_U; LAS unsigned char* XL = lds + L_X;
    const int pa = 8 * wave + 2 * g, pb = pa + 1;
    const f32x2 a1a = APW[1 * 64 + pa], a2a = APW[2 * 64 + pa], a4a = APW[4 * 64 + pa], a8a = APW[8 * 64 + pa], ana = APW[(n16 + 1) * 64 + pa];
    const f32x2 a1b = APW[1 * 64 + pb], a2b = APW[2 * 64 + pb], a4b = APW[4 * 64 + pb], a8b = APW[8 * 64 + pb], anb = APW[(n16 + 1) * 64 + pb];
    f32x2 xia = (f32x2){0.f, 0.f}, xib = (f32x2){0.f, 0.f};
    const bf16_t* usrc = ug + (size_t)item * SEQ * 16;
    for (int half = 0; half < 2; ++half) {
        __syncthreads();
#pragma unroll
        for (int it = 0; it < 8; ++it) { const int e = it * 512 + tid;
            const u32x4 v = *(const u32x4*)(usrc + (size_t)half * 2048 * 16 + (size_t)e * 8);
            *(LAS u32x4*)(UL + (e >> 5) * 528 + (e & 31) * 16) = v; }
        __syncthreads();
    bf16x8 A2[8];
    {
        int opq2 = 0; asm volatile("" : "+v"(opq2)); const int pq = 16 * wave + n16, p = (pq >> 1) + opq2, cbit = pq & 1;
#pragma unroll
        for (int kp = 0; kp < 8; ++kp) { const int s = 2 * kp + (g >> 1); const f32x2 w = PW[(15 - s) * 64 + p]; unsigned pk[4];
#pragma unroll
            for (int i = 0; i < 8; i += 2) { const f32x2 b0 = BB[p * 16 + h8 + i], b1 = BB[p * 16 + h8 + i + 1];
                const float v0 = cbit ? (w.x * b0.y + w.y * b0.x) : (w.x * b0.x - w.y * b0.y), v1 = cbit ? (w.x * b1.y + w.y * b1.x) : (w.x * b1.x - w.y * b1.y);
                pk[i >> 1] = cvt_pk_bf16(v0, v1); }
            A2[kp] = __builtin_bit_cast(bf16x8, (u32x4){pk[0], pk[1], pk[2], pk[3]}); }
    }
        for (int jt = 0; jt < 8; ++jt) {
            const int jl = 16 * jt + n16;
            f32x4 Dv = (f32x4){0.f, 0.f, 0.f, 0.f}; bf16x8 uf8[8];
#pragma unroll
            for (int kp = 0; kp < 8; ++kp) uf8[kp] = *(const LAS bf16x8*)(UL + jl * 528 + (2 * kp + (g >> 1)) * 32 + (g & 1) * 16);
            __builtin_amdgcn_sched_barrier(0);
#pragma unroll
            for (int kp = 0; kp < 8; ++kp) Dv = __builtin_amdgcn_mfma_f32_16x16x32_bf16(A2[kp], uf8[kp], Dv, 0, 0, 0);
            f32x2 da = (f32x2){Dv[0], Dv[1]}, db = (f32x2){Dv[2], Dv[3]};
#define SCAN_STEP(SH, ALA, ALB) { f32x2 ta, tb; ta.x = __shfl_up(da.x, SH, 16); ta.y = __shfl_up(da.y, SH, 16); tb.x = __shfl_up(db.x, SH, 16); tb.y = __shfl_up(db.y, SH, 16); \
              if (n16 < SH) { ta = (f32x2){0.f, 0.f}; tb = (f32x2){0.f, 0.f}; } da += cmul(ALA, ta); db += cmul(ALB, tb); }
            SCAN_STEP(1, a1a, a1b) SCAN_STEP(2, a2a, a2b) SCAN_STEP(4, a4a, a4b) SCAN_STEP(8, a8a, a8b)
#undef SCAN_STEP
            da += cmul(ana, xia); db += cmul(anb, xib);
            f32x2 pa_, pb_; pa_.x = __shfl_up(da.x, 1, 16); pa_.y = __shfl_up(da.y, 1, 16); pb_.x = __shfl_up(db.x, 1, 16); pb_.y = __shfl_up(db.y, 1, 16);
            if (n16 == 0) { pa_ = xia; pb_ = xib; }
            xia.x = __shfl(da.x, 15, 16); xia.y = __shfl(da.y, 15, 16); xib.x = __shfl(db.x, 15, 16); xib.y = __shfl(db.y, 15, 16);
            u32x2 w; w.x = cvt_pk_bf16(pa_.x, pa_.y); w.y = cvt_pk_bf16(pb_.x, pb_.y);
            *(LAS u32x2*)(XL + jl * 272 + (16 * wave + 4 * g) * 2) = w;
        }
        __syncthreads();
    bf16x8 M3[2][4]; int opq3 = 0; asm volatile("" : "+v"(opq3));
#pragma unroll
    for (int ti = 0; ti < 2; ++ti) { const int t = ti ? 15 - wave : wave;
#pragma unroll
        for (int kp = 0; kp < 4; ++kp) { unsigned pk[4];
#pragma unroll
            for (int i = 0; i < 4; ++i) { const int p = 16 * kp + 4 * g + i + opq3; const f32x2 cw = cmul(CC[n16 * 65 + p], PW[(t + 1) * 64 + p]); pk[i] = cvt_pk_bf16(cw.x, -cw.y); }
            M3[ti][kp] = __builtin_bit_cast(bf16x8, (u32x4){pk[0], pk[1], pk[2], pk[3]}); } }
        for (int jt = 0; jt < 8; ++jt) {
            const int jl = 16 * jt + n16;
            int opq = 0; asm volatile("" : "+v"(opq));
            bf16x8 U[8], X[4];
#pragma unroll
            for (int kp = 0; kp < 8; ++kp) U[kp] = *(const LAS bf16x8*)(UL + jl * 528 + (2 * kp + (g >> 1)) * 32 + (g & 1) * 16);
#pragma unroll
            for (int kp = 0; kp < 4; ++kp) X[kp] = *(const LAS bf16x8*)(XL + jl * 272 + 64 * kp + 16 * g);
#pragma unroll
            for (int ti = 0; ti < 2; ++ti) { const int t = ti ? 15 - wave : wave;
                f32x4 Dv = (f32x4){0.f, 0.f, 0.f, 0.f}; bf16x8 kf8[4];
#pragma unroll
                for (int hb = 0; hb < 2; ++hb) {
#pragma unroll
                    for (int kq = 0; kq < 4; ++kq) { const int kp = 4 * hb + kq; int kk = t - (2 * kp + (g >> 1)) + 1; kk = kk < 0 ? 0 : kk; kf8[kq] = *(const LAS bf16x8*)(KT + kk * 256 + n16 * 16 + h8 + opq); }
                    __builtin_amdgcn_sched_barrier(0);
#pragma unroll
                    for (int kq = 0; kq < 4; ++kq) Dv = __builtin_amdgcn_mfma_f32_16x16x32_bf16(kf8[kq], U[4 * hb + kq], Dv, 0, 0, 0);
                    __builtin_amdgcn_sched_barrier(0); }
#pragma unroll
                for (int kp = 0; kp < 4; ++kp) Dv = __builtin_amdgcn_mfma_f32_16x16x32_bf16(M3[ti][kp], X[kp], Dv, 0, 0, 0);
                f32x4 y;
#pragma unroll
                for (int r = 0; r < 4; ++r) y[r] = gelu_tanh(Dv[r]);
                *(u32x2*)(yg + (size_t)(b * SEQ + half * 2048 + 16 * jl + t) * 1024 + 16 * grp + 4 * g) = pack4(y); }
        }
    }
}

constexpr int BIAS_PAD = 384, BIAS_OFF = 128;
typedef short bf16x4 __attribute__((ext_vector_type(4)));
struct AttnTile { bf16x8 K[4]; u32x2 V[8]; };
template <int PAT, int NQ>
__device__ __forceinline__ void attn_pat(const char* kb, const char* vb, const LAS float* rkl, const LAS float* biasp, int blk, int r16, int n16, int g, const int (&tq)[NQ], const float (&nbnd)[NQ],
                                         const bf16x8 (&Qf)[NQ][4], f32x4 (&O)[NQ][8], float (&lsum)[NQ]) {
    constexpr int SH = 2 * PAT, CSTEP = 16 >> SH, Te = PAT == 2 ? 9 : (PAT == 1 ? 12 : 24);
    const int B0 = 4 * blk;
    const int Ts = PAT == 2 ? (blk < 8 ? 8 - blk : 0) : (PAT == 1 ? (blk < 2 ? 8 - 4 * blk : 0) : (blk == 0 ? 8 : 0));
    const int um = n16 >> 2;
    const int klane = PAT == 2 ? 64 * um + 16 * (n16 & 3) + r16 : (PAT == 1 ? 16 * (n16 & 3) + (r16 & 3) + 4 * um : 16 * (n16 & 3) + um);
    const int tlane = PAT == 2 ? 64 * g + r16 : (PAT == 1 ? (r16 & 3) + 4 * g : g);
    const int ulane = PAT == 2 ? 16 * g + r16 : (PAT == 1 ? (r16 & 3) + 4 * g : g);
    const unsigned koff = (unsigned)(klane * 2048 + 16 * g), voff = (unsigned)(ulane * 128 + n16 * 8);
    const LAS float* rl = rkl + 4 * (ulane - 16 * B0 + 512);
    int dq[NQ];
#pragma unroll
    for (int q = 0; q < NQ; ++q) dq[q] = tq[q] - tlane;
    auto tokT = [&](int T) { return PAT == 2 ? 64 * (B0 - 32 + 4 * T) : (PAT == 1 ? 64 * (B0 - 8 + T) : 64 * (B0 - 2 + (T >> 2)) + 4 * (T & 3)); };
    auto unitT = [&](int T) { return PAT == 2 ? 16 * (B0 - 32 + 4 * T) : (PAT == 1 ? 16 * (B0 - 8 + T) : 16 * (B0 - 2 + (T >> 2)) + 4 * (T & 3)); };
    auto load_tile = [&](AttnTile& A, int T) __attribute__((always_inline)) {
        const char* kp_ = kb + (size_t)tokT(T) * 2048; const char* vp_ = vb + (size_t)unitT(T) * 128;
#pragma unroll
        for (int kp = 0; kp < 4; ++kp) A.K[kp] = *(const bf16x8*)(kp_ + koff + 64 * kp);
        if constexpr (NQ == 1) {
#pragma unroll
            for (int nt = 0; nt < 8; ++nt) A.V[nt] = *(const u32x2*)(vp_ + (size_t)nt * 131072 + voff); }
    };
    auto compute_tile = [&](AttnTile& A, int T) __attribute__((always_inline)) {
        if constexpr (NQ == 2) { const char* vp_ = vb + (size_t)unitT(T) * 128;
#pragma unroll
            for (int nt = 0; nt < 8; ++nt) A.V[nt] = *(const u32x2*)(vp_ + (size_t)nt * 131072 + voff); }
        const f32x4 sk = *(const LAS f32x4*)(rl + 4 * unitT(T));
#pragma unroll
        for (int q = 0; q < NQ; ++q) {
            f32x4 S = (f32x4){0.f, 0.f, 0.f, 0.f};
#pragma unroll
            for (int kp = 0; kp < 4; ++kp) S = __builtin_amdgcn_mfma_f32_16x16x32_bf16(A.K[kp], Qf[q][kp], S, 0, 0, 0);
            int d0 = (dq[q] - tokT(T)) >> SH; d0 = d0 < -80 ? -80 : (d0 > 255 ? 255 : d0);
            const LAS float* bp = biasp + d0 - 3 * CSTEP;
            float pv[4];
#pragma unroll
            for (int r = 0; r < 4; ++r) { pv[r] = __builtin_amdgcn_exp2f(S[r] * sk[r] + (bp[CSTEP * (3 - r)] + nbnd[q])); lsum[q] += pv[r]; }
            const bf16x4 Pf = __builtin_bit_cast(bf16x4, (u32x2){cvt_pk_bf16(pv[0], pv[1]), cvt_pk_bf16(pv[2], pv[3])});
#pragma unroll
            for (int nt = 0; nt < 8; ++nt) O[q][nt] = __builtin_amdgcn_mfma_f32_16x16x16bf16_1k(__builtin_bit_cast(bf16x4, A.V[nt]), Pf, O[q][nt], 0, 0, 0);
        }
    };
    AttnTile P0, P1;
    int T = Ts;
    load_tile(P0, T);
    for (;;) {
        if (T + 1 < Te) load_tile(P1, T + 1); compute_tile(P0, T); if (++T >= Te) break;
        if (T + 1 < Te) load_tile(P0, T + 1); compute_tile(P1, T); if (++T >= Te) break;
    }
}
__device__ __forceinline__ void attn_item2(const Params& P, LAS unsigned char* lds, int bhb, int wave, int lane) {
    const int blk = bhb & 15, h = (bhb >> 4) & 7, b = bhb >> 7;
    const int ra = (wave & 3) + 8 * (wave >> 2);
    asm volatile("" : "+v"(lane));
    const int n16 = lane & 15, g = lane >> 4;
    const bf16_t* qg = (const bf16_t*)(P.ws + WS_Q); const bf16_t* kg = (const bf16_t*)(P.ws + WS_K); const bf16_t* vT = (const bf16_t*)(P.ws + WS_VT);
    const float* ssqk = (const float*)(P.ws + WS_SSQK); bf16_t* mixed = (bf16_t*)(P.ws + WS_MIX);
    const LAS float* biasl = (const LAS float*)(lds + L_BIAS) + h * 3 * BIAS_PAD + BIAS_OFF;
    int tq[2]; float nbnd[2]; bf16x8 Qf[2][4];
#pragma unroll
    for (int q = 0; q < 2; ++q) {
        tq[q] = 256 * blk + ra + 4 * q + 16 * n16;
        const f32x4 qp = *(const f32x4*)(ssqk + ((size_t)h * 16384 + perm_tok(b * SEQ + tq[q])) * 4);
        const float rq = __builtin_amdgcn_rsqf(((qp[0] + qp[1]) + (qp[2] + qp[3])) * (1.0f / 128.0f) + pg8::RMS_EPS) * (1.44269504089f * 0.08838834764f);
        float ssum = 0.f;
#pragma unroll
        for (int kp = 0; kp < 4; ++kp) { const int d0 = 32 * kp + 8 * g; const u32x4 raw = *(const u32x4*)(qg + (size_t)(b * SEQ + tq[q]) * 1024 + h * 128 + d0);
            const f32x4 ga = *(const f32x4*)(P.in[7] + d0), gb = *(const f32x4*)(P.in[7] + d0 + 4), ka = *(const f32x4*)(P.in[8] + d0), kb = *(const f32x4*)(P.in[8] + d0 + 4);
            float v[8]; v[0] = bf_lo(raw.x) * ga[0] * ka[0]; v[1] = bf_hi(raw.x) * ga[1] * ka[1]; v[2] = bf_lo(raw.y) * ga[2] * ka[2]; v[3] = bf_hi(raw.y) * ga[3] * ka[3];
            v[4] = bf_lo(raw.z) * gb[0] * kb[0]; v[5] = bf_hi(raw.z) * gb[1] * kb[1]; v[6] = bf_lo(raw.w) * gb[2] * kb[2]; v[7] = bf_hi(raw.w) * gb[3] * kb[3];
#pragma unroll
            for (int i = 0; i < 8; ++i) { v[i] *= rq; ssum += v[i] * v[i]; }
            Qf[q][kp] = __builtin_bit_cast(bf16x8, (u32x4){cvt_pk_bf16(v[0], v[1]), cvt_pk_bf16(v[2], v[3]), cvt_pk_bf16(v[4], v[5]), cvt_pk_bf16(v[6], v[7])}); }
        ssum += __shfl_xor(ssum, 16); ssum += __shfl_xor(ssum, 32);
        nbnd[q] = -(11.3137085f * 1.01f * sqrtf(ssum) + *(const LAS float*)(lds + L_MAXB));
    }
    f32x4 O[2][8]; float lsum[2] = {0.f, 0.f};
#pragma unroll
    for (int q = 0; q < 2; ++q)
#pragma unroll
        for (int nt = 0; nt < 8; ++nt) O[q][nt] = (f32x4){0.f, 0.f, 0.f, 0.f};
    const char* kseq = (const char*)(kg + (size_t)(b * SEQ) * 1024 + h * 128);
    const char* vhead = (const char*)(vT + (size_t)((b * 8 + h) * 8) * 65536);
    const LAS float* rkl = (const LAS float*)(lds + L_RK);
    attn_pat<0, 2>(kseq, vhead, rkl, biasl + 0 * BIAS_PAD, blk, ra, n16, g, tq, nbnd, Qf, O, lsum);
    attn_pat<1, 2>(kseq, vhead, rkl, biasl + 1 * BIAS_PAD, blk, ra, n16, g, tq, nbnd, Qf, O, lsum);
#pragma unroll
    for (int q = 0; q < 2; ++q) {
        const int tq1[1] = {tq[q]}; const float nb1[1] = {nbnd[q]}; bf16x8 Q1[1][4]; f32x4 O1[1][8]; float l1[1] = {lsum[q]};
#pragma unroll
        for (int kp = 0; kp < 4; ++kp) Q1[0][kp] = Qf[q][kp];
#pragma unroll
        for (int nt = 0; nt < 8; ++nt) O1[0][nt] = O[q][nt];
        attn_pat<2, 1>(kseq, vhead, rkl, biasl + 2 * BIAS_PAD, blk, ra + 4 * q, n16, g, tq1, nb1, Q1, O1, l1);
#pragma unroll
        for (int nt = 0; nt < 8; ++nt) O[q][nt] = O1[0][nt];
        lsum[q] = l1[0];
    }
#pragma unroll
    for (int q = 0; q < 2; ++q) {
        float l = lsum[q]; l += __shfl_xor(l, 16); l += __shfl_xor(l, 32);
        const float inv = 1.0f / l;
        bf16_t* op = mixed + (size_t)(b * SEQ + tq[q]) * 2048 + h * 128 + 4 * g;
#pragma unroll
        for (int nt = 0; nt < 8; ++nt) *(u32x2*)(op + 16 * nt) = pack4(O[q][nt] * inv);
    }
}

#define XB_TMO      128
#define XB_XCNT(j)  (256  + 64 * (j))
#define XB_XSUB(j)  (1280 + 64 * (j))
#define XB_XGEN(j)  (2304 + 64 * (j))
#define XB_TOP      3328
#define XB_TOPGEN   3392
#define XCD_BAR_WORDS 3456
#define XB_SPIN_CAP (1u << 18)

__device__ __forceinline__ unsigned xb_ld(unsigned* p)              { return __hip_atomic_load(p, __ATOMIC_RELAXED, __HIP_MEMORY_SCOPE_AGENT); }
__device__ __forceinline__ unsigned xb_add(unsigned* p, unsigned v) { return __hip_atomic_fetch_add(p, v, __ATOMIC_RELAXED, __HIP_MEMORY_SCOPE_AGENT); }
__device__ __forceinline__ unsigned xb_xcc_id() { return (unsigned)__builtin_amdgcn_s_getreg((3 << 11) | 20) & 0xFu; }
#define XB_SPIN(cond, bar) do { unsigned _sp = 0; while (cond) { __builtin_amdgcn_s_sleep(1); \
    if ((++_sp & 255u) == 0u) { if (xb_ld(&(bar)[XB_TMO])) break; if (_sp > XB_SPIN_CAP) { atomicAdd(&(bar)[XB_TMO], 1u); break; } } } } while (0)

struct XcdBarrier {
    unsigned* bar; unsigned x;
    volatile LAS unsigned* st;
};

__device__ __forceinline__ XcdBarrier xcd_barrier_post(unsigned* bar, volatile LAS unsigned* st) {
    XcdBarrier b; b.bar = bar; b.x = xb_xcc_id(); b.st = st;
    if (threadIdx.x == 0) (void)xb_add(&bar[XB_XCNT(b.x)], 1u);
    return b;
}
__device__ __forceinline__ void xcd_barrier_complete(unsigned* bar, unsigned x, unsigned& nloc, unsigned& nx) {
    const unsigned G = gridDim.x * gridDim.y * gridDim.z;
    unsigned sum, cnt, mine, sp = 0u;
    for (;;) {
        sum = 0u; cnt = 0u; mine = 0u;
#pragma unroll
        for (unsigned j = 0; j < 16; ++j) { const unsigned c = xb_ld(&bar[XB_XCNT(j)]); sum += c; cnt += (c > 0u) ? 1u : 0u; mine = (j == x) ? c : mine; }
        if (sum == G) break;
        __builtin_amdgcn_s_sleep(1);
        if ((++sp & 255u) == 0u) { if (xb_ld(&bar[XB_TMO])) break; if (sp > XB_SPIN_CAP) { atomicAdd(&bar[XB_TMO], 1u); break; } }
    }
    nloc = mine > 0u ? mine : 1u; nx = cnt > 0u ? cnt : 1u;
}

__device__ __forceinline__ void xcd_barrier(const XcdBarrier& b) {
    asm volatile("s_waitcnt vmcnt(0)" ::: "memory");
    __syncthreads();
    if (threadIdx.x == 0) {
        unsigned* bar = b.bar;
        __builtin_amdgcn_s_waitcnt(0);
        unsigned nloc = b.st[0], nx = b.st[1];
        if (nloc == 0u) { xcd_barrier_complete(bar, b.x, nloc, nx); b.st[0] = nloc; b.st[1] = nx; }
        const unsigned old = xb_add(&bar[XB_XSUB(b.x)], 1u);
        const unsigned gen = old / nloc;
        if (old + 1u == (gen + 1u) * nloc) {
            __builtin_amdgcn_fence(__ATOMIC_RELEASE, "agent");
            asm volatile("s_waitcnt vmcnt(0)" ::: "memory");
            const unsigned og = xb_add(&bar[XB_TOP], 1u);
            const unsigned tg = og / nx;
            if (og + 1u == (tg + 1u) * nx) xb_add(&bar[XB_TOPGEN], 1u);
            else XB_SPIN(xb_ld(&bar[XB_TOPGEN]) == tg, bar);
            __builtin_amdgcn_fence(__ATOMIC_ACQUIRE, "agent");
            xb_add(&bar[XB_XGEN(b.x)], 1u);
            asm volatile("s_waitcnt vmcnt(0)" ::: "memory");
        } else {
            XB_SPIN(xb_ld(&bar[XB_XGEN(b.x)]) == gen, bar);
            __builtin_amdgcn_fence(__ATOMIC_ACQUIRE, "agent");
            asm volatile("s_waitcnt vmcnt(0)" ::: "memory");
        }
    }
    __syncthreads();
}

__global__ void __launch_bounds__(512, 2) mk_fwd(Params P) {
    extern __shared__ __attribute__((aligned(16))) unsigned char lds_raw[];
    LAS unsigned char* lds = (LAS unsigned char*)lds_raw;
    cg::grid_group grid = cg::this_grid();
    const int tid = threadIdx.x, lane = tid & 63, wave = __builtin_amdgcn_readfirstlane(tid >> 6);
    const int G = gridDim.x, bid = blockIdx.x;
    const int gw = bid * 8 + wave, NGW = G * 8;
    unsigned char* ws = P.ws;
    if (tid < 2) ((volatile LAS unsigned*)(lds + LDS_BYTES - 256))[tid] = 0u;
    __syncthreads();
    const XcdBarrier xbar = xcd_barrier_post((unsigned*)(ws + WS_BAR), (volatile LAS unsigned*)(lds + LDS_BYTES - 256));
    float* ss0 = (float*)(ws + WS_SS0); float* ss1 = (float*)(ws + WS_SS1); float* ss2 = (float*)(ws + WS_SS2); float* ssqk = (float*)(ws + WS_SSQK);
    bf16_t* R1 = (bf16_t*)(ws + WS_R1); bf16_t* Hb = (bf16_t*)(ws + WS_H);

#define IN(k) (P.ph_lo <= (k) && (k) < P.ph_hi)
#define SYNC(k) do { if (IN(k) && IN((k) + 1)) xcd_barrier(xbar); } while (0)
    if (P.ph_hi - P.ph_lo > 1) grid.sync();
    if (IN(0)) {
        for (int m = gw; m < M; m += NGW) {
            const f32x4* xr = (const f32x4*)(P.in[0] + (size_t)m * D) + lane; u32x2* orow = (u32x2*)(R1 + (size_t)m * D) + lane; float s = 0.f;
#pragma unroll
            for (int j = 0; j < 8; ++j) { const f32x4 v = xr[64 * j]; s += (v[0] * v[0] + v[1] * v[1]) + (v[2] * v[2] + v[3] * v[3]); orow[64 * j] = pack4(v); }
            s = wave_sum(s); if (lane == 0) ss0[m] = s;
        }
        LAS float* scr = (LAS float*)(lds + wave * 16384);
        constexpr int I_GU = (D / 64) * (FF / 32), I_DN = (FF / 64) * (D / 32), I_IN = (D / 64) * (NIN / 32), I_GL = (1024 / 64) * (1024 / 32), I_OUT = (D / 64) * (D / 32);
        constexpr int NITEMS = 4 * I_GU + 2 * I_DN + I_IN + I_GL + I_OUT;
        for (int it = gw; it < NITEMS; it += NGW) {
            int r = it;
            if (r < I_GU) { transpose_item<1>(P.in[2], P.in[1], D, FF, (bf16_t*)(ws + WS_WGU1), scr, r, lane); continue; } r -= I_GU;
            if (r < I_GU) { transpose_item<2>(P.in[3], P.in[1], D, FF, (bf16_t*)(ws + WS_WGU1), scr, r, lane); continue; } r -= I_GU;
            if (r < I_DN) { transpose_item<0>(P.in[4], nullptr, FF, D, (bf16_t*)(ws + WS_WD1), scr, r, lane); continue; } r -= I_DN;
            if (r < I_IN) { transpose_item<0>(P.in[6], P.in[5], D, NIN, (bf16_t*)(ws + WS_WIN), scr, r, lane); continue; } r -= I_IN;
            if (r < I_GL) { transpose_item<0>(P.in[18], nullptr, 1024, 1024, (bf16_t*)(ws + WS_WGLU), scr, r, lane); continue; } r -= I_GL;
            if (r < I_OUT) { transpose_item<0>(P.in[20], nullptr, D, D, (bf16_t*)(ws + WS_WOUT), scr, r, lane); continue; } r -= I_OUT;
            if (r < I_GU) { transpose_item<1>(P.in[22], P.in[21], D, FF, (bf16_t*)(ws + WS_WGU2), scr, r, lane); continue; } r -= I_GU;
            if (r < I_GU) { transpose_item<2>(P.in[23], P.in[21], D, FF, (bf16_t*)(ws + WS_WGU2), scr, r, lane); continue; } r -= I_GU;
            transpose_item<0>(P.in[24], nullptr, FF, D, (bf16_t*)(ws + WS_WD2), scr, r, lane);
        }
    }
    SYNC(0);
    if (IN(1)) { pg8::Gemm g{R1, (const bf16_t*)(ws + WS_WGU1), M, 2 * FF, D}; pg8::StaticOrder S; S.init(M, 2 * FF, G, bid); pg8::EpiGateUp E{Hb, ss0, FF, 1};
      pg8::gemm_phase<pg8::EpiGateUp, pg8::StaticOrder, true, true>(lds, g, S, E); }
    SYNC(1);
    if (IN(2)) { pg8::Gemm g{Hb, (const bf16_t*)(ws + WS_WD1), M, D, FF}; pg8::StaticOrder S; S.init(M, D, G, bid); pg8::EpiResid E{nullptr, R1, nullptr, R1, ss1, 0.5f, D};
      pg8::gemm_phase<pg8::EpiResid, pg8::StaticOrder, true, true>(lds, g, S, E); }
    SYNC(2);
    if (IN(3)) { pg8::Gemm g{R1, (const bf16_t*)(ws + WS_WIN), M, NIN, D}; pg8::StaticOrder S; S.init(M, NIN, G, bid);
      pg8::EpiWin E{ss1, (bf16_t*)(ws + WS_Q), ssqk};
      pg8::gemm_phase<pg8::EpiWin, pg8::StaticOrder, true, true>(lds, g, S, E); }
    SYNC(3);
    for (int rep4 = 0; rep4 < DBG_REP4; ++rep4) if (IN(4)) {
        if (rep4) grid.sync();
        for (int rs = 0; rs < DBG_REPS; ++rs) for (int it = bid; it < 256; it += G) ssm_item(P, lds, it, tid, wave, lane);
        __syncthreads();
        LAS float* bl = (LAS float*)(lds + L_BIAS);
        for (int i = tid; i < 8 * 3 * BIAS_PAD; i += 512) { const int hh = i / (3 * BIAS_PAD), rem = i % (3 * BIAS_PAD), pp = rem / BIAS_PAD, dl = rem % BIAS_PAD - BIAS_OFF; bl[i] = (dl >= 0 && dl <= 128) ? P.in[9][(int)P.bucket[pp][dl] * 8 + hh] * 1.44269504089f : -1e30f; }
        if (wave == 0) { float mx = 0.f; for (int i = lane; i < 256; i += 64) mx = fmaxf(mx, fabsf(P.in[9][i]));
#pragma unroll
            for (int o = 1; o < 64; o <<= 1) mx = fmaxf(mx, __shfl_xor(mx, o));
            if (lane == 0) *(LAS float*)(lds + L_MAXB) = mx * 1.44269504089f; }
        __syncthreads();
        for (int bhb = bid; bhb < 512; bhb += G) {
            const int blk_ = bhb & 15, h_ = (bhb >> 4) & 7, b_ = bhb >> 7, Bf = 4 * blk_ - 32;
            LAS float* rkl = (LAS float*)(lds + L_RK);
            f32x4 kp4[5];
#pragma unroll
            for (int it = 0; it < 5; ++it) { int i = tid + 512 * it; i = i < 2304 ? i : 2303; int B = Bf + (i >> 6); B = B < 0 ? 0 : B;
                kp4[it] = *(const f32x4*)(ssqk + ((size_t)(8 + h_) * 16384 + b_ * SEQ + 64 * B + (i & 63)) * 4); }
#pragma unroll
            for (int it = 0; it < 5; ++it) { const int i = tid + 512 * it; const int B = Bf + (i >> 6);
                const float rv = __builtin_amdgcn_rsqf(((kp4[it][0] + kp4[it][1]) + (kp4[it][2] + kp4[it][3])) * (1.0f / 128.0f) + pg8::RMS_EPS);
                if (i < 2304) rkl[i] = B >= 0 ? rv : 0.f; }
            __syncthreads();
            attn_item2(P, lds, bhb, wave, lane);
            __syncthreads();
        }
    }
    SYNC(4);
    if (IN(5)) { pg8::Gemm g{(const bf16_t*)(ws + WS_YG), (const bf16_t*)(ws + WS_WGLU), M, 1024, 1024}; pg8::StaticOrder S; S.init(M, 1024, G, bid); pg8::EpiGlu E{(const bf16_t*)(ws + WS_YG), P.in[19], (bf16_t*)(ws + WS_MIX)};
      pg8::gemm_phase<pg8::EpiGlu, pg8::StaticOrder, true, true>(lds, g, S, E); }
    SYNC(5);
    if (IN(6)) { pg8::Gemm g{(const bf16_t*)(ws + WS_MIX), (const bf16_t*)(ws + WS_WOUT), M, D, D}; pg8::StaticOrder S; S.init(M, D, G, bid); pg8::EpiResid E{nullptr, R1, nullptr, (bf16_t*)(ws + WS_H2B), ss2, 1.0f, D};
      pg8::gemm_phase<pg8::EpiResid, pg8::StaticOrder, true, true>(lds, g, S, E); }
    SYNC(6);
    if (IN(7)) { pg8::Gemm g{(const bf16_t*)(ws + WS_H2B), (const bf16_t*)(ws + WS_WGU2), M, 2 * FF, D}; pg8::StaticOrder S; S.init(M, 2 * FF, G, bid); pg8::EpiGateUp E{Hb, ss2, FF, 32};
      pg8::gemm_phase<pg8::EpiGateUp, pg8::StaticOrder, true, true>(lds, g, S, E); }
    SYNC(7);
    if (IN(8)) { pg8::Gemm g{Hb, (const bf16_t*)(ws + WS_WD2), M, D, FF}; pg8::StaticOrder S; S.init(M, D, G, bid); pg8::EpiResid E{nullptr, (const bf16_t*)(ws + WS_H2B), P.out, nullptr, nullptr, 0.5f, D};
      pg8::gemm_phase<pg8::EpiResid, pg8::StaticOrder, true, true>(lds, g, S, E); }
#ifdef MK_SANITIZE
    SYNC(8);
    if (IN(9)) {
#if DBG_LAST == 3
        { const bf16_t* qr = (const bf16_t*)(ws + WS_Q); for (size_t i = (size_t)bid * 512 + tid; i < (size_t)M * D; i += (size_t)G * 512) P.out[i] = ssqk[i & (size_t)(1048576 - 1)]; }
#elif DBG_LAST == 4
        { const bf16_t* yr = (const bf16_t*)(ws + WS_YG); for (size_t i = (size_t)bid * 512 + tid; i < (size_t)M * D; i += (size_t)G * 512) P.out[i] = DBG_SUB == 3 ? ssqk[i & (size_t)(1048576 - 1)] : (DBG_SUB == 1 ? 0.f : __uint_as_float((unsigned)R1[i] << 16)) + (DBG_SUB == 2 ? 0.f : __uint_as_float((unsigned)yr[i & (size_t)(16777216 - 1)] << 16)); }
#endif
        for (size_t i = (size_t)bid * 512 + tid; i < (size_t)M * D; i += (size_t)G * 512) { const float v = P.out[i]; if (!(fabsf(v) < 1e30f)) P.out[i] = 0.f; } }
#endif
}

extern "C" void kernel_launch(void* const* d_in, const int* in_sizes, int n_in, void* d_out, int out_size, void* d_ws, size_t ws_size, hipStream_t stream) {
    static int grid = 0;
    if (grid == 0) {
        if (n_in != 25 || out_size != M * D || ws_size < WS_END) { fprintf(stderr, "kernel_launch: unexpected shapes (n_in %d, out %d, ws %zu)\n", n_in, out_size, ws_size); grid = -1; return; }
        int dev = 0, cus = 0, per_cu = 0;
        if (hipGetDevice(&dev) != hipSuccess || hipDeviceGetAttribute(&cus, hipDeviceAttributeMultiprocessorCount, dev) != hipSuccess) { grid = -1; return; }
        if (hipFuncSetAttribute((const void*)mk_fwd, hipFuncAttributeMaxDynamicSharedMemorySize, LDS_BYTES) != hipSuccess) { fprintf(stderr, "kernel_launch: hipFuncSetAttribute failed\n"); grid = -1; return; }
        if (hipOccupancyMaxActiveBlocksPerMultiprocessor(&per_cu, (const void*)mk_fwd, 512, LDS_BYTES) != hipSuccess || per_cu < 1) { fprintf(stderr, "kernel_launch: occupancy query says %d blocks per CU\n", per_cu); per_cu = 1; }
        (void)hipGetLastError();
        grid = cus * 1;
    }
    if (grid < 0) return;
    Params p{};
    for (int i = 0; i < 25; ++i) p.in[i] = (const float*)d_in[i];
    p.out = (float*)d_out; p.ws = (unsigned char*)d_ws;
    const int dil[3] = {1, 4, 16};
    for (int pp = 0; pp < 3; ++pp)
        for (int dl = 0; dl <= 128; ++dl) { const int dist = dl * dil[pp]; int bk;
            if (dist < 16) bk = dist; else { bk = 16 + (int)(std::log((double)dist / 16.0) / std::log(128.0) * 16.0); if (bk > 31) bk = 31; }
            p.bucket[pp][dl] = (unsigned char)bk; }
    if (hipMemsetAsync((char*)d_ws + WS_BAR, 0, 16384, stream) != hipSuccess) { fprintf(stderr, "kernel_launch: memset failed\n"); return; }
    if (MK_N_LAUNCHES == 1) {
        p.ph_lo = 0; p.ph_hi = NPH;
        void* args[] = {&p};
        const hipError_t e = hipLaunchCooperativeKernel((const void*)mk_fwd, dim3(grid), dim3(512), args, LDS_BYTES, stream);
        if (e != hipSuccess) fprintf(stderr, "kernel_launch: cooperative launch failed: %s (grid %d)\n", hipGetErrorString(e), grid);
    } else {
        for (int k = 0; k < NPH; ++k) { if (k > DBG_LAST && k != 9) continue; p.ph_lo = k; p.ph_hi = k + 1; hipLaunchKernelGGL(mk_fwd, dim3(grid), dim3(512), LDS_BYTES, stream, p); }
    }
}
```

```cpp
#include <hip/hip_runtime.h>
#include <hip/hip_cooperative_groups.h>
#include <cstdio>
#include <cstdint>
#include <cmath>
namespace cg = cooperative_groups;
namespace pg8 {
#define PG8_LAS __attribute__((address_space(3)))
typedef unsigned short bf16_t;
typedef short bf16x8 __attribute__((ext_vector_type(8)));
typedef float f32x4 __attribute__((ext_vector_type(4)));
typedef unsigned u32x4 __attribute__((ext_vector_type(4)));
constexpr int BM = 256, BK = 64, HALF = 128, HTB = HALF * BK * 2  , STAGE_BYTES = 8 * HTB, NXCD = 8, WGM = 8;

__host__ __device__ __forceinline__ int lds_byte(int r, int c) { const int st = (r >> 4) * 2 + (c >> 5), rr = r & 15, cc = c & 31, ob = rr * 64 + cc * 2; return st * 1024 + (ob ^ (((ob >> 9) & 1) << 5)); }
__host__ __device__ __forceinline__ void stage_rc(int b, int& R, int& C) { const int st = b / 1024, sb = b % 1024, swz = sb ^ (((sb >> 9) & 1) << 5); R = (st >> 1) * 16 + swz / 64; C = (st & 1) * 32 + (swz % 64) / 2; }
__host__ __device__ __forceinline__ int perm32(int rho) { const int n = rho >> 4, i = rho & 15; return 8 * (i >> 2) + 4 * n + (i & 3); }

struct Unit { int pm, pn; };
struct Gemm { const bf16_t* A; const bf16_t* Bt; int M, N, K; };

struct StaticOrder {
    int nM, nN, nwg, G, c;
    __host__ __device__ void init(int M, int N, int G_, int c_) { nM = M / BM; nN = N / BM; nwg = nM * nN; G = G_; c = c_; }
    __host__ __device__ bool next(int i, Unit& u) const {
        const long L = (long)i * G + c; if (L >= nwg) return false;
        int wgid = (int)L; { const int q = nwg / NXCD, r = nwg % NXCD, xcd = wgid % NXCD, off = wgid / NXCD; wgid = (xcd < r ? xcd * (q + 1) : r * (q + 1) + (xcd - r) * q) + off; }
        const int nig = WGM * nN, gid = wgid / nig, fm = gid * WGM, gsz = (nM - fm) < WGM ? (nM - fm) : WGM;
        u.pm = fm + ((wgid % nig) % gsz); u.pn = (wgid % nig) / gsz; return true;
    }
    __device__ __forceinline__ void a_ready(const Unit&) const {}
    __device__ __forceinline__ void done(const Unit&) const {}
};

typedef float f32x2 __attribute__((ext_vector_type(2)));
typedef unsigned u32x2 __attribute__((ext_vector_type(2)));
typedef __bf16 bf16v2_t __attribute__((ext_vector_type(2)));
__device__ __forceinline__ unsigned cvt_pk_bf16(float lo, float hi) { return __builtin_bit_cast(unsigned, __builtin_convertvector((f32x2){lo, hi}, bf16v2_t)); }
__device__ __forceinline__ u32x2 pack4(f32x4 v) { u32x2 w; w.x = cvt_pk_bf16(v[0], v[1]); w.y = cvt_pk_bf16(v[2], v[3]); return w; }
__device__ __forceinline__ float fast_sigmoid(float z) { return __builtin_amdgcn_rcpf(1.0f + __builtin_amdgcn_exp2f(-1.44269504089f * z)); }
constexpr float RMS_EPS = 1e-6f;

__device__ __forceinline__ float row_ss(const float* ssp, int row, int fq, int npart) {
    if (npart == 1) return ssp[row];
    const f32x4 a = *(const f32x4*)(ssp + (size_t)row * 32 + fq * 8), b = *(const f32x4*)(ssp + (size_t)row * 32 + fq * 8 + 4);
    float s = ((a[0] + a[1]) + (a[2] + a[3])) + ((b[0] + b[1]) + (b[2] + b[3])); s += __shfl_xor(s, 16); s += __shfl_xor(s, 32); return s;
}
struct EpiGateUp {
    static constexpr bool PERM = false, AFTER_DRAIN = false;
    bf16_t* H; const float* ss; int ldh; int npart;
    __device__ __forceinline__ void operator()(const f32x4 (&acc)[2][2][4][2], const Unit& u, int wr, int wc, int fr, int fq) const {
        const int row0 = u.pm * BM + wr * 64 + fr, hc0 = u.pn * 128 + wc * 16 + 4 * fq;
        float rinv8[2][4];
#pragma unroll
        for (int ai = 0; ai < 2; ++ai)
#pragma unroll
            for (int m = 0; m < 4; ++m) rinv8[ai][m] = __builtin_amdgcn_rsqf(row_ss(ss, row0 + ai * HALF + m * 16, fq, npart) * (1.0f / 2048.0f) + RMS_EPS);
#pragma unroll
        for (int ai = 0; ai < 2; ++ai)
#pragma unroll
            for (int m = 0; m < 4; ++m) { const int row = row0 + ai * HALF + m * 16; const float rinv = rinv8[ai][m];
                bf16_t* rowp = H + (size_t)row * ldh + hc0;
#pragma unroll
                for (int bj = 0; bj < 2; ++bj) { const f32x4 g = acc[ai][bj][m][0] * rinv, up = acc[ai][bj][m][1] * rinv; f32x4 hv;
#pragma unroll
                    for (int j = 0; j < 4; ++j) hv[j] = g[j] * fast_sigmoid(g[j]) * up[j];
                    *(u32x2*)(rowp + bj * 64) = pack4(hv); } }
    }
};
struct EpiResid {
    static constexpr bool PERM = false, AFTER_DRAIN = false;
    const float* basef; const bf16_t* baseb; float* outf; bf16_t* ob; float* ssacc; float scale; int ldc;
    __device__ __forceinline__ void operator()(const f32x4 (&acc)[2][2][4][2], const Unit& u, int wr, int wc, int fr, int fq) const {
        const int row0 = u.pm * BM + wr * 64 + fr, col0 = u.pn * BM + wc * 32 + 4 * fq;
#pragma unroll
        for (int ai = 0; ai < 2; ++ai)
#pragma unroll
            for (int mp = 0; mp < 2; ++mp) {
                f32x4 bs[2][2][2];
                if (basef) {
#pragma unroll
                    for (int mm = 0; mm < 2; ++mm)
#pragma unroll
                        for (int bj = 0; bj < 2; ++bj)
#pragma unroll
                            for (int n = 0; n < 2; ++n) bs[mm][bj][n] = *(const f32x4*)(basef + (size_t)(row0 + ai * HALF + (2 * mp + mm) * 16) * ldc + col0 + bj * HALF + n * 16);
                } else { u32x2 w[2][2][2];
#pragma unroll
                    for (int mm = 0; mm < 2; ++mm)
#pragma unroll
                        for (int bj = 0; bj < 2; ++bj)
#pragma unroll
                            for (int n = 0; n < 2; ++n) w[mm][bj][n] = *(const u32x2*)(baseb + (size_t)(row0 + ai * HALF + (2 * mp + mm) * 16) * ldc + col0 + bj * HALF + n * 16);
#pragma unroll
                    for (int mm = 0; mm < 2; ++mm)
#pragma unroll
                        for (int bj = 0; bj < 2; ++bj)
#pragma unroll
                            for (int n = 0; n < 2; ++n) bs[mm][bj][n] = (f32x4){__uint_as_float(w[mm][bj][n].x << 16), __uint_as_float(w[mm][bj][n].x & 0xffff0000u), __uint_as_float(w[mm][bj][n].y << 16), __uint_as_float(w[mm][bj][n].y & 0xffff0000u)};
                }
#pragma unroll
                for (int mm = 0; mm < 2; ++mm) { const int m = 2 * mp + mm, row = row0 + ai * HALF + m * 16; const size_t off = (size_t)row * ldc + col0; float s = 0.f;
#pragma unroll
                    for (int bj = 0; bj < 2; ++bj)
#pragma unroll
                        for (int n = 0; n < 2; ++n) { const f32x4 v = bs[mm][bj][n] + acc[ai][bj][m][n] * scale;
                            if (outf) *(f32x4*)(outf + off + bj * HALF + n * 16) = v;
                            if (ob) *(u32x2*)(ob + off + bj * HALF + n * 16) = pack4(v);
                            s += (v[0] * v[0] + v[1] * v[1]) + (v[2] * v[2] + v[3] * v[3]); }
                    if (ssacc) { s += __shfl_xor(s, 16); s += __shfl_xor(s, 32); if (fq == 0) ssacc[(size_t)row * 32 + u.pn * 4 + wc] = s; } }
            }
    }
};
__device__ __forceinline__ int perm_tok(int t) { return (t & ~63) | ((t & 15) << 2) | ((t >> 4) & 3); }
struct EpiWin {
    static constexpr bool PERM = false, AFTER_DRAIN = false; static constexpr size_t SEGSTRIDE = 16u * 1024u * 1024u;
    const float* ss; bf16_t* qkvu; float* ssqk;
    __device__ __forceinline__ void operator()(const f32x4 (&acc)[2][2][4][2], const Unit& u, int wr, int wc, int fr, int fq) const {
        const int seg = u.pn >> 2, ct = (u.pn & 3) * 256;
        const int row0 = u.pm * BM + wr * 64 + fr;
        float rinv[2][4];
#pragma unroll
        for (int ai = 0; ai < 2; ++ai)
#pragma unroll
            for (int m = 0; m < 4; ++m) rinv[ai][m] = __builtin_amdgcn_rsqf(row_ss(ss, row0 + ai * HALF + m * 16, fq, 32) * (1.0f / 2048.0f) + RMS_EPS);
        if (seg == 2) {
#pragma unroll
            for (int ai = 0; ai < 2; ++ai) { const int rb = u.pm * BM + ai * HALF + wr * 64; const int b = rb >> 12, tl = rb & 4095;
#pragma unroll
                for (int bj = 0; bj < 2; ++bj) { const int head = (u.pn & 3) * 2 + bj;
#pragma unroll
                    for (int n = 0; n < 2; ++n)
#pragma unroll
                        for (int j = 0; j < 4; ++j) { const int dim = wc * 32 + n * 16 + 4 * fq + j;
                            const f32x4 v = (f32x4){acc[ai][bj][0][n][j] * rinv[ai][0], acc[ai][bj][1][n][j] * rinv[ai][1], acc[ai][bj][2][n][j] * rinv[ai][2], acc[ai][bj][3][n][j] * rinv[ai][3]};
                            *(u32x2*)(qkvu + 2 * SEGSTRIDE + ((((size_t)((b * 8 + head) * 8 + (wc * 2 + n)) * 1024 + 16 * (tl >> 6) + fr) * 16 + 4 * fq + j) * 4)) = pack4(v); } } }
            return;
        }
        if (seg == 3) {
#pragma unroll
            for (int ai = 0; ai < 2; ++ai)
#pragma unroll
                for (int m = 0; m < 4; ++m) { const int row = row0 + ai * HALF + m * 16; const int b = row >> 12, t = row & 4095;
#pragma unroll
                    for (int bj = 0; bj < 2; ++bj)
#pragma unroll
                        for (int n = 0; n < 2; ++n) { const int grp = 16 * (u.pn & 3) + 8 * bj + 2 * wc + n;
                            *(u32x2*)(qkvu + 3 * SEGSTRIDE + ((size_t)(b * 64 + grp) * 4096 + t) * 16 + 4 * fq) = pack4(acc[ai][bj][m][n] * rinv[ai][m]); } }
            return;
        }
        bf16_t* dst = qkvu + (size_t)seg * SEGSTRIDE;
#pragma unroll
        for (int ai = 0; ai < 2; ++ai)
#pragma unroll
            for (int m = 0; m < 4; ++m) { const int row = row0 + ai * HALF + m * 16; bf16_t* rowp = dst + (size_t)row * 1024 + ct + wc * 32 + 4 * fq;
#pragma unroll
                for (int bj = 0; bj < 2; ++bj) { float s = 0.f;
#pragma unroll
                    for (int n = 0; n < 2; ++n) { const f32x4 v = acc[ai][bj][m][n] * rinv[ai][m]; *(u32x2*)(rowp + bj * HALF + n * 16) = pack4(v);
                        s += (v[0] * v[0] + v[1] * v[1]) + (v[2] * v[2] + v[3] * v[3]); }
                    if (seg < 2) { s += __shfl_xor(s, 16); s += __shfl_xor(s, 32);
                        if (fq == 0) ssqk[((size_t)(seg * 8 + (u.pn & 3) * 2 + bj) * 16384 + perm_tok(row)) * 4 + wc] = s; } } }
    }
};
struct EpiGlu {
    static constexpr bool PERM = false, AFTER_DRAIN = false;
    const bf16_t* yg; const float* bias; bf16_t* mixed;
    __device__ __forceinline__ void operator()(const f32x4 (&acc)[2][2][4][2], const Unit& u, int wr, int wc, int fr, int fq) const {
        const int row0 = u.pm * BM + wr * 64 + fr, col0 = u.pn * BM + wc * 32 + 4 * fq;
        f32x4 bv[2][2];
#pragma unroll
        for (int bj = 0; bj < 2; ++bj)
#pragma unroll
            for (int n = 0; n < 2; ++n) bv[bj][n] = *(const f32x4*)(bias + col0 + bj * HALF + n * 16);
#pragma unroll
        for (int ai = 0; ai < 2; ++ai) { u32x2 yw[4][2][2];
#pragma unroll
            for (int m = 0; m < 4; ++m)
#pragma unroll
                for (int bj = 0; bj < 2; ++bj)
#pragma unroll
                    for (int n = 0; n < 2; ++n) yw[m][bj][n] = *(const u32x2*)(yg + (size_t)(row0 + ai * HALF + m * 16) * 1024 + col0 + bj * HALF + n * 16);
#pragma unroll
            for (int m = 0; m < 4; ++m) { const int row = row0 + ai * HALF + m * 16;
#pragma unroll
                for (int bj = 0; bj < 2; ++bj)
#pragma unroll
                    for (int n = 0; n < 2; ++n) { const int col = col0 + bj * HALF + n * 16; const u32x2 w = yw[m][bj][n];
                        const f32x4 z = acc[ai][bj][m][n] + bv[bj][n]; f32x4 y, o;
                        y[0] = __uint_as_float(w.x << 16); y[1] = __uint_as_float(w.x & 0xffff0000u); y[2] = __uint_as_float(w.y << 16); y[3] = __uint_as_float(w.y & 0xffff0000u);
#pragma unroll
                        for (int j = 0; j < 4; ++j) o[j] = y[j] * fast_sigmoid(z[j]);
                        *(u32x2*)(mixed + (size_t)row * 2048 + 1024 + col) = pack4(o); } } }
    }
};
template <class Epi, class Sched, bool ALIGN_EPI = false, bool SP2 = false>
__device__ __forceinline__ void gemm_phase(PG8_LAS unsigned char* lds, const Gemm g, const Sched& S, const Epi& E) {
    const int tid = threadIdx.x, wid = __builtin_amdgcn_readfirstlane(tid >> 6), lane = tid & 63, wr = wid >> 2, wc = wid & 3, fr = lane & 15, fq = lane >> 4;
    const int K = g.K, nt = K / BK;
    unsigned voffA[2], voffB[2];
#pragma unroll
    for (int i = 0; i < 2; ++i) { int R, C; stage_rc(tid * 16 + i * 8192, R, C); const int Rb = Epi::PERM ? ((R & ~31) + perm32(R & 31)) : R;
        voffA[i] = (unsigned)(R * K + C) * 2u; voffB[i] = (unsigned)(Rb * K + C) * 2u; }
    const size_t kstep = (size_t)(BK * 2);
    const size_t hstep = (size_t)HALF * K * 2;
    const size_t tstep = 2 * hstep;
    const unsigned ldsw = (unsigned)wid * 1024u;
    const int aoff = lds_byte(wr * 64 + fr, fq * 8), boff = lds_byte(wc * 32 + fr, fq * 8);
#define PG8_SA(b, h) (((b) * 2 + (h)) * HTB)
#define PG8_SB(b, h) ((4 + (b) * 2 + (h)) * HTB)
#define PG8_STAGE(bufoff, gbase, voff) do { _Pragma("unroll") for (int _i = 0; _i < 2; ++_i) \
        __builtin_amdgcn_global_load_lds((const unsigned*)((const char*)(gbase) + (voff)[_i]), (PG8_LAS unsigned*)(lds + (bufoff) + ldsw + _i * 8192), 16, 0, 0); } while (0)
#define PG8_LDA(dst, b, h) do { _Pragma("unroll") for (int m = 0; m < 4; ++m) _Pragma("unroll") for (int k = 0; k < 2; ++k) dst[m][k] = *(const PG8_LAS bf16x8*)(lds + PG8_SA(b, h) + aoff + m * 2048 + k * 1024); } while (0)
#define PG8_LDB(dst, b, h) do { _Pragma("unroll") for (int n = 0; n < 2; ++n) _Pragma("unroll") for (int k = 0; k < 2; ++k) dst[n][k] = *(const PG8_LAS bf16x8*)(lds + PG8_SB(b, h) + boff + n * 2048 + k * 1024); } while (0)
#define PG8_MMA(ai, bj, At, Bt) do { __builtin_amdgcn_s_setprio(1); _Pragma("unroll") for (int m = 0; m < 4; ++m) _Pragma("unroll") for (int n = 0; n < 2; ++n) _Pragma("unroll") for (int k = 0; k < 2; ++k) \
        acc[ai][bj][m][n] = __builtin_amdgcn_mfma_f32_16x16x32_bf16(Bt[n][k], At[m][k], acc[ai][bj][m][n], 0, 0, 0); __builtin_amdgcn_s_setprio(0); } while (0)
#define PG8_WAIT_V(n) asm volatile("s_waitcnt vmcnt(" #n ")" ::: "memory")
#define PG8_WAIT_L(n) asm volatile("s_waitcnt lgkmcnt(" #n ")" ::: "memory")
#define PG8_BAR __builtin_amdgcn_s_barrier()
#define PG8_SCHED __builtin_amdgcn_sched_barrier(0)
    Unit cur, nxt; int ui = 0;
    if (!S.next(0, cur)) return;
    f32x4 acc[2][2][4][2];
#pragma unroll
    for (int a = 0; a < 2; ++a)
#pragma unroll
        for (int b = 0; b < 2; ++b)
#pragma unroll
            for (int m = 0; m < 4; ++m)
#pragma unroll
                for (int n = 0; n < 2; ++n) acc[a][b][m][n] = (f32x4){0.f, 0.f, 0.f, 0.f};
    bf16x8 At[4][2], B0[2][2], B1[2][2];
    const char* cA = (const char*)g.A + (size_t)cur.pm * tstep; const char* cB = (const char*)g.Bt + (size_t)cur.pn * tstep;
    S.a_ready(cur);
    if constexpr (SP2) {
        PG8_STAGE(PG8_SB(0, 0), cB, voffB); PG8_STAGE(PG8_SB(0, 1), cB + hstep, voffB); PG8_STAGE(PG8_SA(0, 0), cA, voffA); PG8_STAGE(PG8_SA(0, 1), cA + hstep, voffA);
        if (wr == 1) PG8_BAR;
        PG8_WAIT_V(2); PG8_BAR;
        PG8_STAGE(PG8_SB(1, 0), cB + kstep, voffB); PG8_STAGE(PG8_SA(1, 0), cA + kstep, voffA); PG8_STAGE(PG8_SB(1, 1), cB + hstep + kstep, voffB);
        PG8_WAIT_V(6); PG8_BAR;
    } else {
        PG8_STAGE(PG8_SB(0, 0), cB, voffB); PG8_STAGE(PG8_SA(0, 0), cA, voffA); PG8_STAGE(PG8_SB(0, 1), cB + hstep, voffB); PG8_STAGE(PG8_SA(0, 1), cA + hstep, voffA);
        if (wr == 1) PG8_BAR;
        PG8_WAIT_V(4); PG8_BAR;
        PG8_STAGE(PG8_SB(1, 0), cB + kstep, voffB); PG8_STAGE(PG8_SA(1, 0), cA + kstep, voffA); PG8_STAGE(PG8_SB(1, 1), cB + hstep + kstep, voffB);
        PG8_WAIT_V(6); PG8_BAR;
    }
    for (;;) {
        const bool has_next = S.next(ui + 1, nxt);
        const char* nA = has_next ? (const char*)g.A + (size_t)nxt.pm * tstep : cA; const char* nB = has_next ? (const char*)g.Bt + (size_t)nxt.pn * tstep : cB;
        for (int t = 0; t < nt; t += 2) {
            const bool last = (t == nt - 2);
            const char* a1 = cA + (size_t)(t + 1) * kstep;
            const char* a2 = last ? nA : cA + (size_t)(t + 2) * kstep; const char* b2 = last ? nB : cB + (size_t)(t + 2) * kstep;
            const char* a3 = a2 + kstep; const char* b3 = b2 + kstep;
            if (last && has_next) S.a_ready(nxt);
            if constexpr (SP2) {
            PG8_LDB(B0, 0, 0); PG8_LDB(B1, 0, 1); PG8_SCHED; PG8_LDA(At, 0, 0); PG8_STAGE(PG8_SA(1, 1), a1 + hstep, voffA);
            PG8_WAIT_V(8); PG8_WAIT_L(0); PG8_BAR; PG8_MMA(0, 0, At, B0); PG8_MMA(0, 1, At, B1); PG8_BAR; PG8_SCHED;
            PG8_LDA(At, 0, 1); PG8_STAGE(PG8_SB(0, 0), b2, voffB); PG8_STAGE(PG8_SB(0, 1), b2 + hstep, voffB); PG8_STAGE(PG8_SA(0, 0), a2, voffA);
            PG8_WAIT_V(8); PG8_WAIT_L(0); PG8_BAR; PG8_MMA(1, 0, At, B0); PG8_MMA(1, 1, At, B1); PG8_BAR; PG8_SCHED;
            PG8_LDB(B0, 1, 0); PG8_LDB(B1, 1, 1); PG8_SCHED; PG8_LDA(At, 1, 0); PG8_STAGE(PG8_SA(0, 1), a2 + hstep, voffA);
            PG8_WAIT_V(8); PG8_WAIT_L(0); PG8_BAR; PG8_MMA(0, 0, At, B0); PG8_MMA(0, 1, At, B1); PG8_BAR; PG8_SCHED;
            PG8_LDA(At, 1, 1); PG8_STAGE(PG8_SB(1, 0), b3, voffB); PG8_STAGE(PG8_SB(1, 1), b3 + hstep, voffB); PG8_STAGE(PG8_SA(1, 0), a3, voffA);
            PG8_WAIT_V(8); PG8_WAIT_L(0); PG8_BAR; PG8_MMA(1, 0, At, B0); PG8_MMA(1, 1, At, B1); PG8_BAR; PG8_SCHED;
            } else {
            PG8_LDB(B0, 0, 0); PG8_SCHED; PG8_LDA(At, 0, 0); PG8_STAGE(PG8_SA(1, 1), a1 + hstep, voffA);
            PG8_WAIT_L(8); PG8_BAR; PG8_WAIT_L(0); PG8_MMA(0, 0, At, B0); PG8_BAR; PG8_SCHED;
            PG8_LDB(B1, 0, 1); PG8_STAGE(PG8_SB(0, 0), b2, voffB);
            PG8_BAR; PG8_WAIT_L(0); PG8_MMA(0, 1, At, B1); PG8_BAR;
            PG8_LDA(At, 0, 1); PG8_STAGE(PG8_SA(0, 0), a2, voffA);
            PG8_BAR; PG8_WAIT_L(0); PG8_MMA(1, 0, At, B0); PG8_BAR; PG8_SCHED;
            PG8_STAGE(PG8_SB(0, 1), b2 + hstep, voffB);
            PG8_WAIT_V(6); PG8_BAR; PG8_MMA(1, 1, At, B1); PG8_BAR;
            PG8_LDB(B0, 1, 0); PG8_SCHED; PG8_LDA(At, 1, 0); PG8_STAGE(PG8_SA(0, 1), a2 + hstep, voffA);
            PG8_WAIT_L(8); PG8_BAR; PG8_WAIT_L(0); PG8_MMA(0, 0, At, B0); PG8_BAR; PG8_SCHED;
            PG8_LDB(B1, 1, 1); PG8_STAGE(PG8_SB(1, 0), b3, voffB);
            PG8_BAR; PG8_WAIT_L(0); PG8_MMA(0, 1, At, B1); PG8_BAR;
            PG8_LDA(At, 1, 1); PG8_STAGE(PG8_SA(1, 0), a3, voffA);
            PG8_BAR; PG8_WAIT_L(0); PG8_MMA(1, 0, At, B0); PG8_BAR; PG8_SCHED;
            PG8_STAGE(PG8_SB(1, 1), b3 + hstep, voffB);
            PG8_WAIT_V(6); PG8_BAR; PG8_MMA(1, 1, At, B1); PG8_BAR;
            }
        }
        if constexpr (ALIGN_EPI) { if (wr == 0) PG8_BAR; }
        if constexpr (!Epi::AFTER_DRAIN) { E(acc, cur, wr, wc, fr, fq); S.done(cur); }
        if (!has_next) break;
#pragma unroll
        for (int a = 0; a < 2; ++a)
#pragma unroll
            for (int b = 0; b < 2; ++b)
#pragma unroll
                for (int m = 0; m < 4; ++m)
#pragma unroll
                    for (int n = 0; n < 2; ++n) acc[a][b][m][n] = (f32x4){0.f, 0.f, 0.f, 0.f};
        cur = nxt; cA = nA; cB = nB; ++ui;
        if constexpr (ALIGN_EPI) { if (wr == 1) PG8_BAR; }
    }
    PG8_WAIT_V(0);
    if constexpr (!ALIGN_EPI) { if (wr == 0) PG8_BAR; }
    PG8_BAR;
    if constexpr (Epi::AFTER_DRAIN) { E.fused(acc, cur, wr, wc, fr, fq, lds, wid, lane); S.done(cur); }
#undef PG8_SA
#undef PG8_SB
#undef PG8_STAGE
#undef PG8_LDA
#undef PG8_LDB
#undef PG8_MMA
#undef PG8_WAIT_V
#undef PG8_WAIT_L
#undef PG8_BAR
#undef PG8_SCHED
}
}

#define LAS __attribute__((address_space(3)))
typedef unsigned short bf16_t;
typedef short bf16x8 __attribute__((ext_vector_type(8)));
typedef float f32x4 __attribute__((ext_vector_type(4)));
typedef float f32x2 __attribute__((ext_vector_type(2)));
typedef unsigned u32x4 __attribute__((ext_vector_type(4)));
typedef unsigned u32x2 __attribute__((ext_vector_type(2)));
using pg8::cvt_pk_bf16; using pg8::pack4; using pg8::perm_tok;

constexpr int M = 16384, D = 2048, FF = 5632, NIN = 4096, SEQ = 4096;
constexpr size_t MiB = 1u << 20;
constexpr size_t WS_SS0 = 402 * MiB, WS_SS1 = 403 * MiB, WS_SS2 = 405 * MiB, WS_SSQK = 407 * MiB;
constexpr size_t WS_WGU1 = 4 * MiB, WS_WD1 = 48 * MiB, WS_WIN = 70 * MiB, WS_WGLU = 86 * MiB, WS_WOUT = 88 * MiB, WS_WGU2 = 96 * MiB, WS_WD2 = 140 * MiB;
constexpr size_t WS_H2B = 4 * MiB;
constexpr size_t WS_R1 = 162 * MiB;
constexpr size_t WS_H = 226 * MiB;
constexpr size_t WS_Q = 226 * MiB, WS_K = 258 * MiB, WS_VT = 290 * MiB, WS_U = 322 * MiB, WS_YG = 354 * MiB, WS_XT = 386 * MiB;
constexpr size_t WS_BAR = 411 * MiB, WS_MIX = 412 * MiB, WS_END = 476 * MiB;
static_assert(WS_K - WS_Q == 32 * MiB && WS_VT - WS_Q == 64 * MiB && WS_U - WS_Q == 96 * MiB, "q|k|vT|u spacing");
constexpr int LDS_BYTES = 147456;

struct Params { const float* in[25]; float* out; unsigned char* ws; unsigned char bucket[3][136]; int ph_lo, ph_hi; };
#ifndef DBG_REPS
#define DBG_REPS 1
#endif
#ifndef DBG_REP4
#define DBG_REP4 1
#endif
#ifndef DBG_LAST
#define DBG_LAST 9
#define DBG_SUB 0
#define DBG_NOQ 0
#define DBG_NOK 0
#endif
#ifdef MK_SANITIZE
constexpr int NPH = 10;
#else
constexpr int NPH = 9;
#endif
#ifndef MK_N_LAUNCHES
#define MK_N_LAUNCHES 1
#endif

__device__ __forceinline__ float wave_sum(float v) {
#pragma unroll
    for (int o = 1; o < 64; o <<= 1) v += __shfl_xor(v, o);
    return v;
}
__device__ __forceinline__ float bf_lo(unsigned w) { return __uint_as_float(w << 16); }
__device__ __forceinline__ float bf_hi(unsigned w) { return __uint_as_float(w & 0xffff0000u); }

template <int MODE>
__device__ __forceinline__ void transpose_item(const float* __restrict__ W, const float* __restrict__ gain, int K, int N, bf16_t* WT, LAS float* scr, int item, int lane) {
    const int nblk = N / 32, kb = item / nblk, nb = item % nblk, k0 = 64 * kb, n0 = 32 * nb;
    float wv[32];
#pragma unroll
    for (int i = 0; i < 32; ++i) wv[i] = __builtin_nontemporal_load(W + (size_t)(k0 + 2 * i + (lane >> 5)) * N + n0 + (lane & 31));
    if (gain) {
#pragma unroll
        for (int i = 0; i < 32; ++i) wv[i] *= gain[k0 + 2 * i + (lane >> 5)]; }
#pragma unroll
    for (int i = 0; i < 32; ++i) scr[(2 * i + (lane >> 5)) * 33 + (lane & 31)] = wv[i];
    asm volatile("s_waitcnt lgkmcnt(0)" ::: "memory");
    const int c = lane & 7;
#pragma unroll
    for (int j = 0; j < 4; ++j) { const int n = (lane >> 3) + 8 * j; const LAS float* s = scr + (8 * c) * 33 + n;
        u32x4 o; o.x = cvt_pk_bf16(s[0 * 33], s[1 * 33]); o.y = cvt_pk_bf16(s[2 * 33], s[3 * 33]); o.z = cvt_pk_bf16(s[4 * 33], s[5 * 33]); o.w = cvt_pk_bf16(s[6 * 33], s[7 * 33]);
        const int ng = n0 + n; const int row = MODE == 0 ? ng : (32 * (ng >> 4) + (MODE == 2 ? 16 : 0) + (ng & 15));
        *(u32x4*)(WT + (size_t)row * K + k0 + 8 * c) = o; }
    asm volatile("s_waitcnt lgkmcnt(0)" ::: "memory");
}

__device__ __forceinline__ void sincos_d(double th, double& sn, double& cs) {
    const double k = rint(th * 0.63661977236758134308);
    double r = fma(-k, 1.57079632679489655800e+00, th); r = fma(-k, 6.12323399573676603587e-17, r);
    const long long q = (long long)k;
    const double r2 = r * r;
    double sp = -7.6471637318198164759e-13; sp = fma(sp, r2, 1.6059043836821614599e-10); sp = fma(sp, r2, -2.5052108385441718775e-08); sp = fma(sp, r2, 2.7557319223985890653e-06);
    sp = fma(sp, r2, -1.9841269841269841270e-04); sp = fma(sp, r2, 8.3333333333333333333e-03); sp = fma(sp, r2, -1.6666666666666666667e-01); const double s = fma(sp * r2, r, r);
    double cp = 4.7794773323873852974e-14; cp = fma(cp, r2, -1.1470745597729724714e-11); cp = fma(cp, r2, 2.0876756987868098979e-09); cp = fma(cp, r2, -2.7557319223985890653e-07);
    cp = fma(cp, r2, 2.4801587301587301587e-05); cp = fma(cp, r2, -1.3888888888888888889e-03); cp = fma(cp, r2, 4.1666666666666666667e-02); cp = fma(cp, r2, -0.5); const double c = fma(cp, r2, 1.0);
    const int qq = (int)(q & 3);
    sn = (qq == 0) ? s : (qq == 1) ? c : (qq == 2) ? -s : -c;
    cs = (qq == 0) ? c : (qq == 1) ? -s : (qq == 2) ? -c : s;
}
__device__ __forceinline__ double exp_d(double x) {
    const double k = rint(x * 1.44269504088896340736);
    double r = fma(-k, 6.93147180369123816490e-01, x); r = fma(-k, 1.90821492927058770002e-10, r);
    double p = 1.0 / 6227020800.0; p = fma(p, r, 1.0 / 479001600.0); p = fma(p, r, 1.0 / 39916800.0); p = fma(p, r, 1.0 / 3628800.0); p = fma(p, r, 1.0 / 362880.0); p = fma(p, r, 1.0 / 40320.0);
    p = fma(p, r, 1.0 / 5040.0); p = fma(p, r, 1.0 / 720.0); p = fma(p, r, 1.0 / 120.0); p = fma(p, r, 1.0 / 24.0); p = fma(p, r, 1.0 / 6.0); p = fma(p, r, 0.5); p = fma(p, r, 1.0); p = fma(p, r, 1.0);
    const long long e = (long long)k + 1023; const double sc = __longlong_as_double(e << 52);
    return p * sc;
}

__device__ __forceinline__ f32x2 cmul(f32x2 a, f32x2 b) { return (f32x2){a.x * b.x - a.y * b.y, a.x * b.y + a.y * b.x}; }
__device__ __forceinline__ float gelu_tanh(float x) { const float z = 0.7978845608f * (x + 0.044715f * x * x * x); return x * __builtin_amdgcn_rcpf(1.0f + __builtin_amdgcn_exp2f(-2.88539008178f * z)); }

constexpr int L_PW = 0, L_APW = 8704, L_BB = 17408, L_CC = 25600, L_KT = 33920, L_BIAS = 49152, L_MAXB = 49152 + 36864, L_RK = 90112, L_U = 42624, L_X = 42624 + 67584;
__device__ __forceinline__ void ssm_item(const Params& P, LAS unsigned char* lds, int item, int tid, int wave, int lane) {
    const int b = item >> 6, grp = item & 63;
    LAS f32x2* PW = (LAS f32x2*)(lds + L_PW); LAS f32x2* APW = (LAS f32x2*)(lds + L_APW); LAS f32x2* BB = (LAS f32x2*)(lds + L_BB); LAS f32x2* CC = (LAS f32x2*)(lds + L_CC);
    LAS bf16_t* KT = (LAS bf16_t*)(lds + L_KT);
    const bf16_t* ug = (const bf16_t*)(P.ws + WS_U); bf16_t* yg = (bf16_t*)(P.ws + WS_YG);
    float ccr[2], cci[2];
#pragma unroll
    for (int it = 0; it < 2; ++it) { ccr[it] = P.in[15][(size_t)grp * 1024 + tid + 512 * it]; cci[it] = P.in[16][(size_t)grp * 1024 + tid + 512 * it]; }
    __syncthreads();
#pragma unroll
    for (int it = 0; it < 2; ++it) { const int idx = tid + 512 * it; CC[(idx >> 6) * 65 + (idx & 63)] = (f32x2){ccr[it], cci[it]}; }
    if (tid < 64) {
        const int p = tid;
        const float lr_f = P.in[10][grp * 64 + p], li_f = P.in[11][grp * 64 + p], ldt_f = P.in[12][grp];
        f32x4 brv[4], biv[4];
#pragma unroll
        for (int c = 0; c < 4; ++c) { brv[c] = *(const f32x4*)(P.in[13] + (size_t)(grp * 64 + p) * 16 + 4 * c); biv[c] = *(const f32x4*)(P.in[14] + (size_t)(grp * 64 + p) * 16 + 4 * c); }
        __builtin_amdgcn_sched_barrier(0);
        const double lr = (double)lr_f, li = (double)li_f, dt = exp_d((double)ldt_f);
        const double mag = exp_d(lr * dt); double sn, cs; sincos_d(li * dt, sn, cs);
        const double ar = mag * cs, ai = mag * sn, zr = ar - 1.0, zi = ai, den = lr * lr + li * li;
        const double cr = (zr * lr + zi * li) / den, ci = (zi * lr - zr * li) / den;
        double pr = 1.0, pi = 0.0, alr = 1.0, ali = 0.0;
        for (int e = 0; e <= 16; ++e) { PW[e * 64 + p] = (f32x2){(float)pr, (float)pi}; if (e == 16) { alr = pr; ali = pi; } const double nr = pr * ar - pi * ai, ni = pr * ai + pi * ar; pr = nr; pi = ni; }
        pr = 1.0; pi = 0.0;
        for (int e = 0; e <= 16; ++e) { APW[e * 64 + p] = (f32x2){(float)pr, (float)pi}; const double nr = pr * alr - pi * ali, ni = pr * ali + pi * alr; pr = nr; pi = ni; }
#pragma unroll
        for (int c = 0; c < 16; ++c) { const double br = brv[c >> 2][c & 3], bi = biv[c >> 2][c & 3]; BB[p * 16 + c] = (f32x2){(float)(cr * br - ci * bi), (float)(cr * bi + ci * br)}; }
    }
    __syncthreads();
    {
        const int k = tid >> 5, co = (tid >> 1) & 15, ch = tid & 1; float acc[8];
#pragma unroll
        for (int c = 0; c < 8; ++c) acc[c] = 0.f;
        for (int p = 0; p < 64; p += 2) {
            f32x2 bb[2][8], cc[2], pw[2];
#pragma unroll
            for (int q = 0; q < 2; ++q) { cc[q] = CC[co * 65 + p + q]; pw[q] = PW[k * 64 + p + q];
#pragma unroll
                for (int c = 0; c < 8; ++c) bb[q][c] = BB[(p + q) * 16 + 8 * ch + c]; }
            __builtin_amdgcn_sched_barrier(0);
#pragma unroll
            for (int q = 0; q < 2; ++q) { const f32x2 w = cmul(cc[q], pw[q]);
#pragma unroll
                for (int c = 0; c < 8; ++c) acc[c] += w.x * bb[q][c].x - w.y * bb[q][c].y; }
        }
        const float dv = (k == 0) ? P.in[17][grp * 16 + co] : 0.f;
        unsigned pk[4];
#pragma unroll
        for (int c = 0; c < 8; c += 2) { const float v0 = acc[c] + ((8 * ch + c == co) ? dv : 0.f), v1 = acc[c + 1] + ((8 * ch + c + 1 == co) ? dv : 0.f); pk[c >> 1] = cvt_pk_bf16(v0, v1); }
        *(LAS u32x4*)(KT + (k + 1) * 256 + co * 16 + 8 * ch) = (u32x4){pk[0], pk[1], pk[2], pk[3]};
        if (tid < 128) *(LAS unsigned*)(KT + 2 * tid) = 0u;
    }
    const int n16 = lane & 15, g = lane >> 4, h8 = (g & 1) * 8;
    LAS unsigned char* UL = lds + L_U; LAS unsigned char* XL = lds + L_X;
    const int pa = 8 * wave + 2 * g, pb = pa + 1;
    const f32x2 a1a = APW[1 * 64 + pa], a2a = APW[2 * 64 + pa], a4a = APW[4 * 64 + pa], a8a = APW[8 * 64 + pa], ana = APW[(n16 + 1) * 64 + pa];
    const f32x2 a1b = APW[1 * 64 + pb], a2b = APW[2 * 64 + pb], a4b = APW[4 * 64 + pb], a8b = APW[8 * 64 + pb], anb = APW[(n16 + 1) * 64 + pb];
    f32x2 xia = (f32x2){0.f, 0.f}, xib = (f32x2){0.f, 0.f};
    const bf16_t* usrc = ug + (size_t)item * SEQ * 16;
    for (int half = 0; half < 2; ++half) {
        __syncthreads();
#pragma unroll
        for (int it = 0; it < 8; ++it) { const int e = it * 512 + tid;
            const u32x4 v = *(const u32x4*)(usrc + (size_t)half * 2048 * 16 + (size_t)e * 8);
            *(LAS u32x4*)(UL + (e >> 5) * 528 + (e & 31) * 16) = v; }
        __syncthreads();
    bf16x8 A2[8];
    {
        int opq2 = 0; asm volatile("" : "+v"(opq2)); const int pq = 16 * wave + n16, p = (pq >> 1) + opq2, cbit = pq & 1;
#pragma unroll
        for (int kp = 0; kp < 8; ++kp) { const int s = 2 * kp + (g >> 1); const f32x2 w = PW[(15 - s) * 64 + p]; unsigned pk[4];
#pragma unroll
            for (int i = 0; i < 8; i += 2) { const f32x2 b0 = BB[p * 16 + h8 + i], b1 = BB[p * 16 + h8 + i + 1];
                const float v0 = cbit ? (w.x * b0.y + w.y * b0.x) : (w.x * b0.x - w.y * b0.y), v1 = cbit ? (w.x * b1.y + w.y * b1.x) : (w.x * b1.x - w.y * b1.y);
                pk[i >> 1] = cvt_pk_bf16(v0, v1); }
            A2[kp] = __builtin_bit_cast(bf16x8, (u32x4){pk[0], pk[1], pk[2], pk[3]}); }
    }
        for (int jt = 0; jt < 8; ++jt) {
            const int jl = 16 * jt + n16;
            f32x4 Dv = (f32x4){0.f, 0.f, 0.f, 0.f}; bf16x8 uf8[8];
#pragma unroll
            for (int kp = 0; kp < 8; ++kp) uf8[kp] = *(const LAS bf16x8*)(UL + jl * 528 + (2 * kp + (g >> 1)) * 32 + (g & 1) * 16);
            __builtin_amdgcn_sched_barrier(0);
#pragma unroll
            for (int kp = 0; kp < 8; ++kp) Dv = __builtin_amdgcn_mfma_f32_16x16x32_bf16(A2[kp], uf8[kp], Dv, 0, 0, 0);
            f32x2 da = (f32x2){Dv[0], Dv[1]}, db = (f32x2){Dv[2], Dv[3]};
#define SCAN_STEP(SH, ALA, ALB) { f32x2 ta, tb; ta.x = __shfl_up(da.x, SH, 16); ta.y = __shfl_up(da.y, SH, 16); tb.x = __shfl_up(db.x, SH, 16); tb.y = __shfl_up(db.y, SH, 16); \
              if (n16 < SH) { ta = (f32x2){0.f, 0.f}; tb = (f32x2){0.f, 0.f}; } da += cmul(ALA, ta); db += cmul(ALB, tb); }
            SCAN_STEP(1, a1a, a1b) SCAN_STEP(2, a2a, a2b) SCAN_STEP(4, a4a, a4b) SCAN_STEP(8, a8a, a8b)
#undef SCAN_STEP
            da += cmul(ana, xia); db += cmul(anb, xib);
            f32x2 pa_, pb_; pa_.x = __shfl_up(da.x, 1, 16); pa_.y = __shfl_up(da.y, 1, 16); pb_.x = __shfl_up(db.x, 1, 16); pb_.y = __shfl_up(db.y, 1, 16);
            if (n16 == 0) { pa_ = xia; pb_ = xib; }
            xia.x = __shfl(da.x, 15, 16); xia.y = __shfl(da.y, 15, 16); xib.x = __shfl(db.x, 15, 16); xib.y = __shfl(db.y, 15, 16);
            u32x2 w; w.x = cvt_pk_bf16(pa_.x, pa_.y); w.y = cvt_pk_bf16(pb_.x, pb_.y);
            *(LAS u32x2*)(XL + jl * 272 + (16 * wave + 4 * g) * 2) = w;
        }
        __syncthreads();
    bf16x8 M3[2][4]; int opq3 = 0; asm volatile("" : "+v"(opq3));
#pragma unroll
    for (int ti = 0; ti < 2; ++ti) { const int t = ti ? 15 - wave : wave;
#pragma unroll
        for (int kp = 0; kp < 4; ++kp) { unsigned pk[4];
#pragma unroll
            for (int i = 0; i < 4; ++i) { const int p = 16 * kp + 4 * g + i + opq3; const f32x2 cw = cmul(CC[n16 * 65 + p], PW[(t + 1) * 64 + p]); pk[i] = cvt_pk_bf16(cw.x, -cw.y); }
            M3[ti][kp] = __builtin_bit_cast(bf16x8, (u32x4){pk[0], pk[1], pk[2], pk[3]}); } }
        for (int jt = 0; jt < 8; ++jt) {
            const int jl = 16 * jt + n16;
            int opq = 0; asm volatile("" : "+v"(opq));
            bf16x8 U[8], X[4];
#pragma unroll
            for (int kp = 0; kp < 8; ++kp) U[kp] = *(const LAS bf16x8*)(UL + jl * 528 + (2 * kp + (g >> 1)) * 32 + (g & 1) * 16);
#pragma unroll
            for (int kp = 0; kp < 4; ++kp) X[kp] = *(const LAS bf16x8*)(XL + jl * 272 + 64 * kp + 16 * g);
#pragma unroll
            for (int ti = 0; ti < 2; ++ti) { const int t = ti ? 15 - wave : wave;
                f32x4 Dv = (f32x4){0.f, 0.f, 0.f, 0.f}; bf16x8 kf8[4];
#pragma unroll
                for (int hb = 0; hb < 2; ++hb) {
#pragma unroll
                    for (int kq = 0; kq < 4; ++kq) { const int kp = 4 * hb + kq; int kk = t - (2 * kp + (g >> 1)) + 1; kk = kk < 0 ? 0 : kk; kf8[kq] = *(const LAS bf16x8*)(KT + kk * 256 + n16 * 16 + h8 + opq); }
                    __builtin_amdgcn_sched_barrier(0);
#pragma unroll
                    for (int kq = 0; kq < 4; ++kq) Dv = __builtin_amdgcn_mfma_f32_16x16x32_bf16(kf8[kq], U[4 * hb + kq], Dv, 0, 0, 0);
                    __builtin_amdgcn_sched_barrier(0); }
#pragma unroll
                for (int kp = 0; kp < 4; ++kp) Dv = __builtin_amdgcn_mfma_f32_16x16x32_bf16(M3[ti][kp], X[kp], Dv, 0, 0, 0);
                f32x4 y;
#pragma unroll
                for (int r = 0; r < 4; ++r) y[r] = gelu_tanh(Dv[r]);
                *(u32x2*)(yg + (size_t)(b * SEQ + half * 2048 + 16 * jl + t) * 1024 + 16 * grp + 4 * g) = pack4(y); }
        }
    }
}

constexpr int BIAS_PAD = 384, BIAS_OFF = 128;
typedef short bf16x4 __attribute__((ext_vector_type(4)));
struct AttnTile { bf16x8 K[4]; u32x2 V[8]; };
template <int PAT, int NQ>
__device__ __forceinline__ void attn_pat(const char* kb, const char* vb, const LAS float* rkl, const LAS float* biasp, int blk, int r16, int n16, int g, const int (&tq)[NQ], const float (&nbnd)[NQ],
                                         const bf16x8 (&Qf)[NQ][4], f32x4 (&O)[NQ][8], float (&lsum)[NQ]) {
    constexpr int SH = 2 * PAT, CSTEP = 16 >> SH, Te = PAT == 2 ? 9 : (PAT == 1 ? 12 : 24);
    const int B0 = 4 * blk;
    const int Ts = PAT == 2 ? (blk < 8 ? 8 - blk : 0) : (PAT == 1 ? (blk < 2 ? 8 - 4 * blk : 0) : (blk == 0 ? 8 : 0));
    const int um = n16 >> 2;
    const int klane = PAT == 2 ? 64 * um + 16 * (n16 & 3) + r16 : (PAT == 1 ? 16 * (n16 & 3) + (r16 & 3) + 4 * um : 16 * (n16 & 3) + um);
    const int tlane = PAT == 2 ? 64 * g + r16 : (PAT == 1 ? (r16 & 3) + 4 * g : g);
    const int ulane = PAT == 2 ? 16 * g + r16 : (PAT == 1 ? (r16 & 3) + 4 * g : g);
    const unsigned koff = (unsigned)(klane * 2048 + 16 * g), voff = (unsigned)(ulane * 128 + n16 * 8);
    const LAS float* rl = rkl + 4 * (ulane - 16 * B0 + 512);
    int dq[NQ];
#pragma unroll
    for (int q = 0; q < NQ; ++q) dq[q] = tq[q] - tlane;
    auto tokT = [&](int T) { return PAT == 2 ? 64 * (B0 - 32 + 4 * T) : (PAT == 1 ? 64 * (B0 - 8 + T) : 64 * (B0 - 2 + (T >> 2)) + 4 * (T & 3)); };
    auto unitT = [&](int T) { return PAT == 2 ? 16 * (B0 - 32 + 4 * T) : (PAT == 1 ? 16 * (B0 - 8 + T) : 16 * (B0 - 2 + (T >> 2)) + 4 * (T & 3)); };
    auto load_tile = [&](AttnTile& A, int T) __attribute__((always_inline)) {
        const char* kp_ = kb + (size_t)tokT(T) * 2048; const char* vp_ = vb + (size_t)unitT(T) * 128;
#pragma unroll
        for (int kp = 0; kp < 4; ++kp) A.K[kp] = *(const bf16x8*)(kp_ + koff + 64 * kp);
        if constexpr (NQ == 1) {
#pragma unroll
            for (int nt = 0; nt < 8; ++nt) A.V[nt] = *(const u32x2*)(vp_ + (size_t)nt * 131072 + voff); }
    };
    auto compute_tile = [&](AttnTile& A, int T) __attribute__((always_inline)) {
        if constexpr (NQ == 2) { const char* vp_ = vb + (size_t)unitT(T) * 128;
#pragma unroll
            for (int nt = 0; nt < 8; ++nt) A.V[nt] = *(const u32x2*)(vp_ + (size_t)nt * 131072 + voff); }
        const f32x4 sk = *(const LAS f32x4*)(rl + 4 * unitT(T));
#pragma unroll
        for (int q = 0; q < NQ; ++q) {
            f32x4 S = (f32x4){0.f, 0.f, 0.f, 0.f};
#pragma unroll
            for (int kp = 0; kp < 4; ++kp) S = __builtin_amdgcn_mfma_f32_16x16x32_bf16(A.K[kp], Qf[q][kp], S, 0, 0, 0);
            int d0 = (dq[q] - tokT(T)) >> SH; d0 = d0 < -80 ? -80 : (d0 > 255 ? 255 : d0);
            const LAS float* bp = biasp + d0 - 3 * CSTEP;
            float pv[4];
#pragma unroll
            for (int r = 0; r < 4; ++r) { pv[r] = __builtin_amdgcn_exp2f(S[r] * sk[r] + (bp[CSTEP * (3 - r)] + nbnd[q])); lsum[q] += pv[r]; }
            const bf16x4 Pf = __builtin_bit_cast(bf16x4, (u32x2){cvt_pk_bf16(pv[0], pv[1]), cvt_pk_bf16(pv[2], pv[3])});
#pragma unroll
            for (int nt = 0; nt < 8; ++nt) O[q][nt] = __builtin_amdgcn_mfma_f32_16x16x16bf16_1k(__builtin_bit_cast(bf16x4, A.V[nt]), Pf, O[q][nt], 0, 0, 0);
        }
    };
    AttnTile P0, P1;
    int T = Ts;
    load_tile(P0, T);
    for (;;) {
        if (T + 1 < Te) load_tile(P1, T + 1); compute_tile(P0, T); if (++T >= Te) break;
        if (T + 1 < Te) load_tile(P0, T + 1); compute_tile(P1, T); if (++T >= Te) break;
    }
}
__device__ __forceinline__ void attn_item2(const Params& P, LAS unsigned char* lds, int bhb, int wave, int lane) {
    const int blk = bhb & 15, h = (bhb >> 4) & 7, b = bhb >> 7;
    const int ra = (wave & 3) + 8 * (wave >> 2);
    asm volatile("" : "+v"(lane));
    const int n16 = lane & 15, g = lane >> 4;
    const bf16_t* qg = (const bf16_t*)(P.ws + WS_Q); const bf16_t* kg = (const bf16_t*)(P.ws + WS_K); const bf16_t* vT = (const bf16_t*)(P.ws + WS_VT);
    const float* ssqk = (const float*)(P.ws + WS_SSQK); bf16_t* mixed = (bf16_t*)(P.ws + WS_MIX);
    const LAS float* biasl = (const LAS float*)(lds + L_BIAS) + h * 3 * BIAS_PAD + BIAS_OFF;
    int tq[2]; float nbnd[2]; bf16x8 Qf[2][4];
#pragma unroll
    for (int q = 0; q < 2; ++q) {
        tq[q] = 256 * blk + ra + 4 * q + 16 * n16;
        const f32x4 qp = *(const f32x4*)(ssqk + ((size_t)h * 16384 + perm_tok(b * SEQ + tq[q])) * 4);
        const float rq = __builtin_amdgcn_rsqf(((qp[0] + qp[1]) + (qp[2] + qp[3])) * (1.0f / 128.0f) + pg8::RMS_EPS) * (1.44269504089f * 0.08838834764f);
        float ssum = 0.f;
#pragma unroll
        for (int kp = 0; kp < 4; ++kp) { const int d0 = 32 * kp + 8 * g; const u32x4 raw = *(const u32x4*)(qg + (size_t)(b * SEQ + tq[q]) * 1024 + h * 128 + d0);
            const f32x4 ga = *(const f32x4*)(P.in[7] + d0), gb = *(const f32x4*)(P.in[7] + d0 + 4), ka = *(const f32x4*)(P.in[8] + d0), kb = *(const f32x4*)(P.in[8] + d0 + 4);
            float v[8]; v[0] = bf_lo(raw.x) * ga[0] * ka[0]; v[1] = bf_hi(raw.x) * ga[1] * ka[1]; v[2] = bf_lo(raw.y) * ga[2] * ka[2]; v[3] = bf_hi(raw.y) * ga[3] * ka[3];
            v[4] = bf_lo(raw.z) * gb[0] * kb[0]; v[5] = bf_hi(raw.z) * gb[1] * kb[1]; v[6] = bf_lo(raw.w) * gb[2] * kb[2]; v[7] = bf_hi(raw.w) * gb[3] * kb[3];
#pragma unroll
            for (int i = 0; i < 8; ++i) { v[i] *= rq; ssum += v[i] * v[i]; }
            Qf[q][kp] = __builtin_bit_cast(bf16x8, (u32x4){cvt_pk_bf16(v[0], v[1]), cvt_pk_bf16(v[2], v[3]), cvt_pk_bf16(v[4], v[5]), cvt_pk_bf16(v[6], v[7])}); }
        ssum += __shfl_xor(ssum, 16); ssum += __shfl_xor(ssum, 32);
        nbnd[q] = -(11.3137085f * 1.01f * sqrtf(ssum) + *(const LAS float*)(lds + L_MAXB));
    }
    f32x4 O[2][8]; float lsum[2] = {0.f, 0.f};
#pragma unroll
    for (int q = 0; q < 2; ++q)
#pragma unroll
        for (int nt = 0; nt < 8; ++nt) O[q][nt] = (f32x4){0.f, 0.f, 0.f, 0.f};
    const char* kseq = (const char*)(kg + (size_t)(b * SEQ) * 1024 + h * 128);
    const char* vhead = (const char*)(vT + (size_t)((b * 8 + h) * 8) * 65536);
    const LAS float* rkl = (const LAS float*)(lds + L_RK);
    attn_pat<0, 2>(kseq, vhead, rkl, biasl + 0 * BIAS_PAD, blk, ra, n16, g, tq, nbnd, Qf, O, lsum);
    attn_pat<1, 2>(kseq, vhead, rkl, biasl + 1 * BIAS_PAD, blk, ra, n16, g, tq, nbnd, Qf, O, lsum);
#pragma unroll
    for (int q = 0; q < 2; ++q) {
        const int tq1[1] = {tq[q]}; const float nb1[1] = {nbnd[q]}; bf16x8 Q1[1][4]; f32x4 O1[1][8]; float l1[1] = {lsum[q]};
#pragma unroll
        for (int kp = 0; kp < 4; ++kp) Q1[0][kp] = Qf[q][kp];
#pragma unroll
        for (int nt = 0; nt < 8; ++nt) O1[0][nt] = O[q][nt];
        attn_pat<2, 1>(kseq, vhead, rkl, biasl + 2 * BIAS_PAD, blk, ra + 4 * q, n16, g, tq1, nb1, Q1, O1, l1);
#pragma unroll
        for (int nt = 0; nt < 8; ++nt) O[q][nt] = O1[0][nt];
        lsum[q] = l1[0];
    }
#pragma unroll
    for (int q = 0; q < 2; ++q) {
        float l = lsum[q]; l += __shfl_xor(l, 16); l += __shfl_xor(l, 32);
        const float inv = 1.0f / l;
        bf16_t* op = mixed + (size_t)(b * SEQ + tq[q]) * 2048 + h * 128 + 4 * g;
#pragma unroll
        for (int nt = 0; nt < 8; ++nt) *(u32x2*)(op + 16 * nt) = pack4(O[q][nt] * inv);
    }
}

#define XB_TMO      128
#define XB_XCNT(j)  (256  + 64 * (j))
#define XB_XSUB(j)  (1280 + 64 * (j))
#define XB_XGEN(j)  (2304 + 64 * (j))
#define XB_TOP      3328
#define XB_TOPGEN   3392
#define XCD_BAR_WORDS 3456
#define XB_SPIN_CAP (1u << 18)

__device__ __forceinline__ unsigned xb_ld(unsigned* p)              { return __hip_atomic_load(p, __ATOMIC_RELAXED, __HIP_MEMORY_SCOPE_AGENT); }
__device__ __forceinline__ unsigned xb_add(unsigned* p, unsigned v) { return __hip_atomic_fetch_add(p, v, __ATOMIC_RELAXED, __HIP_MEMORY_SCOPE_AGENT); }
__device__ __forceinline__ unsigned xb_xcc_id() { return (unsigned)__builtin_amdgcn_s_getreg((3 << 11) | 20) & 0xFu; }
#define XB_SPIN(cond, bar) do { unsigned _sp = 0; while (cond) { __builtin_amdgcn_s_sleep(1); \
    if ((++_sp & 255u) == 0u) { if (xb_ld(&(bar)[XB_TMO])) break; if (_sp > XB_SPIN_CAP) { atomicAdd(&(bar)[XB_TMO], 1u); break; } } } } while (0)

struct XcdBarrier {
    unsigned* bar; unsigned x;
    volatile LAS unsigned* st;
};

__device__ __forceinline__ XcdBarrier xcd_barrier_post(unsigned* bar, volatile LAS unsigned* st) {
    XcdBarrier b; b.bar = bar; b.x = xb_xcc_id(); b.st = st;
    if (threadIdx.x == 0) (void)xb_add(&bar[XB_XCNT(b.x)], 1u);
    return b;
}
__device__ __forceinline__ void xcd_barrier_complete(unsigned* bar, unsigned x, unsigned& nloc, unsigned& nx) {
    const unsigned G = gridDim.x * gridDim.y * gridDim.z;
    unsigned sum, cnt, mine, sp = 0u;
    for (;;) {
        sum = 0u; cnt = 0u; mine = 0u;
#pragma unroll
        for (unsigned j = 0; j < 16; ++j) { const unsigned c = xb_ld(&bar[XB_XCNT(j)]); sum += c; cnt += (c > 0u) ? 1u : 0u; mine = (j == x) ? c : mine; }
        if (sum == G) break;
        __builtin_amdgcn_s_sleep(1);
        if ((++sp & 255u) == 0u) { if (xb_ld(&bar[XB_TMO])) break; if (sp > XB_SPIN_CAP) { atomicAdd(&bar[XB_TMO], 1u); break; } }
    }
    nloc = mine > 0u ? mine : 1u; nx = cnt > 0u ? cnt : 1u;
}

__device__ __forceinline__ void xcd_barrier(const XcdBarrier& b) {
    asm volatile("s_waitcnt vmcnt(0)" ::: "memory");
    __syncthreads();
    if (threadIdx.x == 0) {
        unsigned* bar = b.bar;
        __builtin_amdgcn_s_waitcnt(0);
        unsigned nloc = b.st[0], nx = b.st[1];
        if (nloc == 0u) { xcd_barrier_complete(bar, b.x, nloc, nx); b.st[0] = nloc; b.st[1] = nx; }
        const unsigned old = xb_add(&bar[XB_XSUB(b.x)], 1u);
        const unsigned gen = old / nloc;
        if (old + 1u == (gen + 1u) * nloc) {
            __builtin_amdgcn_fence(__ATOMIC_RELEASE, "agent");
            asm volatile("s_waitcnt vmcnt(0)" ::: "memory");
            const unsigned og = xb_add(&bar[XB_TOP], 1u);
            const unsigned tg = og / nx;
            if (og + 1u == (tg + 1u) * nx) xb_add(&bar[XB_TOPGEN], 1u);
            else XB_SPIN(xb_ld(&bar[XB_TOPGEN]) == tg, bar);
            __builtin_amdgcn_fence(__ATOMIC_ACQUIRE, "agent");
            xb_add(&bar[XB_XGEN(b.x)], 1u);
            asm volatile("s_waitcnt vmcnt(0)" ::: "memory");
        } else {
            XB_SPIN(xb_ld(&bar[XB_XGEN(b.x)]) == gen, bar);
            __builtin_amdgcn_fence(__ATOMIC_ACQUIRE, "agent");
            asm volatile("s_waitcnt vmcnt(0)" ::: "memory");
        }
    }
    __syncthreads();
}

__global__ void __launch_bounds__(512, 2) mk_fwd(Params P) {
    extern __shared__ __attribute__((aligned(16))) unsigned char lds_raw[];
    LAS unsigned char* lds = (LAS unsigned char*)lds_raw;
    cg::grid_group grid = cg::this_grid();
    const int tid = threadIdx.x, lane = tid & 63, wave = __builtin_amdgcn_readfirstlane(tid >> 6);
    const int G = gridDim.x, bid = blockIdx.x;
    const int gw = bid * 8 + wave, NGW = G * 8;
    unsigned char* ws = P.ws;
    if (tid < 2) ((volatile LAS unsigned*)(lds + LDS_BYTES - 256))[tid] = 0u;
    __syncthreads();
    if (P.ph_hi - P.ph_lo > 1) {
        if (bid == 0) for (int i = tid; i < 4096; i += 512) ((unsigned*)(ws + WS_BAR))[i] = 0u;
        grid.sync();
    }
    const XcdBarrier xbar = xcd_barrier_post((unsigned*)(ws + WS_BAR), (volatile LAS unsigned*)(lds + LDS_BYTES - 256));
    float* ss0 = (float*)(ws + WS_SS0); float* ss1 = (float*)(ws + WS_SS1); float* ss2 = (float*)(ws + WS_SS2); float* ssqk = (float*)(ws + WS_SSQK);
    bf16_t* R1 = (bf16_t*)(ws + WS_R1); bf16_t* Hb = (bf16_t*)(ws + WS_H);

#define IN(k) (P.ph_lo <= (k) && (k) < P.ph_hi)
#define SYNC(k) do { if (IN(k) && IN((k) + 1)) xcd_barrier(xbar); } while (0)
    if (IN(0)) {
        for (int m = gw; m < M; m += NGW) {
            const f32x4* xr = (const f32x4*)(P.in[0] + (size_t)m * D) + lane; u32x2* orow = (u32x2*)(R1 + (size_t)m * D) + lane; float s = 0.f;
#pragma unroll
            for (int j = 0; j < 8; ++j) { const f32x4 v = xr[64 * j]; s += (v[0] * v[0] + v[1] * v[1]) + (v[2] * v[2] + v[3] * v[3]); orow[64 * j] = pack4(v); }
            s = wave_sum(s); if (lane == 0) ss0[m] = s;
        }
        LAS float* scr = (LAS float*)(lds + wave * 16384);
        constexpr int I_GU = (D / 64) * (FF / 32), I_DN = (FF / 64) * (D / 32), I_IN = (D / 64) * (NIN / 32), I_GL = (1024 / 64) * (1024 / 32), I_OUT = (D / 64) * (D / 32);
        constexpr int NITEMS = 4 * I_GU + 2 * I_DN + I_IN + I_GL + I_OUT;
        for (int it = gw; it < NITEMS; it += NGW) {
            int r = it;
            if (r < I_GU) { transpose_item<1>(P.in[2], P.in[1], D, FF, (bf16_t*)(ws + WS_WGU1), scr, r, lane); continue; } r -= I_GU;
            if (r < I_GU) { transpose_item<2>(P.in[3], P.in[1], D, FF, (bf16_t*)(ws + WS_WGU1), scr, r, lane); continue; } r -= I_GU;
            if (r < I_DN) { transpose_item<0>(P.in[4], nullptr, FF, D, (bf16_t*)(ws + WS_WD1), scr, r, lane); continue; } r -= I_DN;
            if (r < I_IN) { transpose_item<0>(P.in[6], P.in[5], D, NIN, (bf16_t*)(ws + WS_WIN), scr, r, lane); continue; } r -= I_IN;
            if (r < I_GL) { transpose_item<0>(P.in[18], nullptr, 1024, 1024, (bf16_t*)(ws + WS_WGLU), scr, r, lane); continue; } r -= I_GL;
            if (r < I_OUT) { transpose_item<0>(P.in[20], nullptr, D, D, (bf16_t*)(ws + WS_WOUT), scr, r, lane); continue; } r -= I_OUT;
            if (r < I_GU) { transpose_item<1>(P.in[22], P.in[21], D, FF, (bf16_t*)(ws + WS_WGU2), scr, r, lane); continue; } r -= I_GU;
            if (r < I_GU) { transpose_item<2>(P.in[23], P.in[21], D, FF, (bf16_t*)(ws + WS_WGU2), scr, r, lane); continue; } r -= I_GU;
            transpose_item<0>(P.in[24], nullptr, FF, D, (bf16_t*)(ws + WS_WD2), scr, r, lane);
        }
    }
    SYNC(0);
    if (IN(1)) { pg8::Gemm g{R1, (const bf16_t*)(ws + WS_WGU1), M, 2 * FF, D}; pg8::StaticOrder S; S.init(M, 2 * FF, G, bid); pg8::EpiGateUp E{Hb, ss0, FF, 1};
      pg8::gemm_phase<pg8::EpiGateUp, pg8::StaticOrder, true, true>(lds, g, S, E); }
    SYNC(1);
    if (IN(2)) { pg8::Gemm g{Hb, (const bf16_t*)(ws + WS_WD1), M, D, FF}; pg8::StaticOrder S; S.init(M, D, G, bid); pg8::EpiResid E{P.in[0], nullptr, nullptr, R1, ss1, 0.5f, D};
      pg8::gemm_phase<pg8::EpiResid, pg8::StaticOrder, true, true>(lds, g, S, E); }
    SYNC(2);
    if (IN(3)) { pg8::Gemm g{R1, (const bf16_t*)(ws + WS_WIN), M, NIN, D}; pg8::StaticOrder S; S.init(M, NIN, G, bid);
      pg8::EpiWin E{ss1, (bf16_t*)(ws + WS_Q), ssqk};
      pg8::gemm_phase<pg8::EpiWin, pg8::StaticOrder, true, true>(lds, g, S, E); }
    SYNC(3);
    for (int rep4 = 0; rep4 < DBG_REP4; ++rep4) if (IN(4)) {
        if (rep4) grid.sync();
        for (int rs = 0; rs < DBG_REPS; ++rs) for (int it = bid; it < 256; it += G) ssm_item(P, lds, it, tid, wave, lane);
        __syncthreads();
        LAS float* bl = (LAS float*)(lds + L_BIAS);
        for (int i = tid; i < 8 * 3 * BIAS_PAD; i += 512) { const int hh = i / (3 * BIAS_PAD), rem = i % (3 * BIAS_PAD), pp = rem / BIAS_PAD, dl = rem % BIAS_PAD - BIAS_OFF; bl[i] = (dl >= 0 && dl <= 128) ? P.in[9][(int)P.bucket[pp][dl] * 8 + hh] * 1.44269504089f : -1e30f; }
        if (wave == 0) { float mx = 0.f; for (int i = lane; i < 256; i += 64) mx = fmaxf(mx, fabsf(P.in[9][i]));
#pragma unroll
            for (int o = 1; o < 64; o <<= 1) mx = fmaxf(mx, __shfl_xor(mx, o));
            if (lane == 0) *(LAS float*)(lds + L_MAXB) = mx * 1.44269504089f; }
        __syncthreads();
        for (int bhb = bid; bhb < 512; bhb += G) {
            const int blk_ = bhb & 15, h_ = (bhb >> 4) & 7, b_ = bhb >> 7, Bf = 4 * blk_ - 32;
            LAS float* rkl = (LAS float*)(lds + L_RK);
            f32x4 kp4[5];
#pragma unroll
            for (int it = 0; it < 5; ++it) { int i = tid + 512 * it; i = i < 2304 ? i : 2303; int B = Bf + (i >> 6); B = B < 0 ? 0 : B;
                kp4[it] = *(const f32x4*)(ssqk + ((size_t)(8 + h_) * 16384 + b_ * SEQ + 64 * B + (i & 63)) * 4); }
#pragma unroll
            for (int it = 0; it < 5; ++it) { const int i = tid + 512 * it; const int B = Bf + (i >> 6);
                const float rv = __builtin_amdgcn_rsqf(((kp4[it][0] + kp4[it][1]) + (kp4[it][2] + kp4[it][3])) * (1.0f / 128.0f) + pg8::RMS_EPS);
                if (i < 2304) rkl[i] = B >= 0 ? rv : 0.f; }
            __syncthreads();
            attn_item2(P, lds, bhb, wave, lane);
            __syncthreads();
        }
    }
    SYNC(4);
    if (IN(5)) { pg8::Gemm g{(const bf16_t*)(ws + WS_YG), (const bf16_t*)(ws + WS_WGLU), M, 1024, 1024}; pg8::StaticOrder S; S.init(M, 1024, G, bid); pg8::EpiGlu E{(const bf16_t*)(ws + WS_YG), P.in[19], (bf16_t*)(ws + WS_MIX)};
      pg8::gemm_phase<pg8::EpiGlu, pg8::StaticOrder, true, true>(lds, g, S, E); }
    SYNC(5);
    if (IN(6)) { pg8::Gemm g{(const bf16_t*)(ws + WS_MIX), (const bf16_t*)(ws + WS_WOUT), M, D, D}; pg8::StaticOrder S; S.init(M, D, G, bid); pg8::EpiResid E{nullptr, R1, nullptr, (bf16_t*)(ws + WS_H2B), ss2, 1.0f, D};
      pg8::gemm_phase<pg8::EpiResid, pg8::StaticOrder, true, true>(lds, g, S, E); }
    SYNC(6);
    if (IN(7)) { pg8::Gemm g{(const bf16_t*)(ws + WS_H2B), (const bf16_t*)(ws + WS_WGU2), M, 2 * FF, D}; pg8::StaticOrder S; S.init(M, 2 * FF, G, bid); pg8::EpiGateUp E{Hb, ss2, FF, 32};
      pg8::gemm_phase<pg8::EpiGateUp, pg8::StaticOrder, true, true>(lds, g, S, E); }
    SYNC(7);
    if (IN(8)) { pg8::Gemm g{Hb, (const bf16_t*)(ws + WS_WD2), M, D, FF}; pg8::StaticOrder S; S.init(M, D, G, bid); pg8::EpiResid E{nullptr, (const bf16_t*)(ws + WS_H2B), P.out, nullptr, nullptr, 0.5f, D};
      pg8::gemm_phase<pg8::EpiResid, pg8::StaticOrder, true, true>(lds, g, S, E); }
#ifdef MK_SANITIZE
    SYNC(8);
    if (IN(9)) {
#if DBG_LAST == 3
        { const bf16_t* qr = (const bf16_t*)(ws + WS_Q); for (size_t i = (size_t)bid * 512 + tid; i < (size_t)M * D; i += (size_t)G * 512) P.out[i] = ssqk[i & (size_t)(1048576 - 1)]; }
#elif DBG_LAST == 4
        { const bf16_t* yr = (const bf16_t*)(ws + WS_YG); for (size_t i = (size_t)bid * 512 + tid; i < (size_t)M * D; i += (size_t)G * 512) P.out[i] = DBG_SUB == 3 ? ssqk[i & (size_t)(1048576 - 1)] : (DBG_SUB == 1 ? 0.f : __uint_as_float((unsigned)R1[i] << 16)) + (DBG_SUB == 2 ? 0.f : __uint_as_float((unsigned)yr[i & (size_t)(16777216 - 1)] << 16)); }
#endif
        for (size_t i = (size_t)bid * 512 + tid; i < (size_t)M * D; i += (size_t)G * 512) { const float v = P.out[i]; if (!(fabsf(v) < 1e30f)) P.out[i] = 0.f; } }
#endif
}

extern "C" void kernel_launch(void* const* d_in, const int* in_sizes, int n_in, void* d_out, int out_size, void* d_ws, size_t ws_size, hipStream_t stream) {
    static int grid = 0;
    if (grid == 0) {
        if (n_in != 25 || out_size != M * D || ws_size < WS_END) { fprintf(stderr, "kernel_launch: unexpected shapes (n_in %d, out %d, ws %zu)\n", n_in, out_size, ws_size); grid = -1; return; }
        int dev = 0, cus = 0, per_cu = 0;
        if (hipGetDevice(&dev) != hipSuccess || hipDeviceGetAttribute(&cus, hipDeviceAttributeMultiprocessorCount, dev) != hipSuccess) { grid = -1; return; }
        if (hipFuncSetAttribute((const void*)mk_fwd, hipFuncAttributeMaxDynamicSharedMemorySize, LDS_BYTES) != hipSuccess) { fprintf(stderr, "kernel_launch: hipFuncSetAttribute failed\n"); grid = -1; return; }
        if (hipOccupancyMaxActiveBlocksPerMultiprocessor(&per_cu, (const void*)mk_fwd, 512, LDS_BYTES) != hipSuccess || per_cu < 1) { fprintf(stderr, "kernel_launch: occupancy query says %d blocks per CU\n", per_cu); per_cu = 1; }
        (void)hipGetLastError();
        grid = cus * 1;
    }
    if (grid < 0) return;
    Params p{};
    for (int i = 0; i < 25; ++i) p.in[i] = (const float*)d_in[i];
    p.out = (float*)d_out; p.ws = (unsigned char*)d_ws;
    const int dil[3] = {1, 4, 16};
    for (int pp = 0; pp < 3; ++pp)
        for (int dl = 0; dl <= 128; ++dl) { const int dist = dl * dil[pp]; int bk;
            if (dist < 16) bk = dist; else { bk = 16 + (int)(std::log((double)dist / 16.0) / std::log(128.0) * 16.0); if (bk > 31) bk = 31; }
            p.bucket[pp][dl] = (unsigned char)bk; }
    if (MK_N_LAUNCHES != 1) { if (hipMemsetAsync((char*)d_ws + WS_BAR, 0, 16384, stream) != hipSuccess) { fprintf(stderr, "kernel_launch: memset failed\n"); return; } }
    if (MK_N_LAUNCHES == 1) {
        p.ph_lo = 0; p.ph_hi = NPH;
        void* args[] = {&p};
        const hipError_t e = hipLaunchCooperativeKernel((const void*)mk_fwd, dim3(grid), dim3(512), args, LDS_BYTES, stream);
        if (e != hipSuccess) fprintf(stderr, "kernel_launch: cooperative launch failed: %s (grid %d)\n", hipGetErrorString(e), grid);
    } else {
        for (int k = 0; k < NPH; ++k) { if (k > DBG_LAST && k != 9) continue; p.ph_lo = k; p.ph_hi = k + 1; hipLaunchKernelGGL(mk_fwd, dim3(grid), dim3(512), LDS_BYTES, stream, p); }
    }
}
```

```cpp
#include <hip/hip_runtime.h>
#include <hip/hip_cooperative_groups.h>
#include <cstdio>
#include <cstdint>
#include <cmath>
namespace cg = cooperative_groups;
namespace pg8 {
#define PG8_LAS __attribute__((address_space(3)))
typedef unsigned short bf16_t;
typedef short bf16x8 __attribute__((ext_vector_type(8)));
typedef float f32x4 __attribute__((ext_vector_type(4)));
typedef unsigned u32x4 __attribute__((ext_vector_type(4)));
constexpr int BM = 256, BK = 64, HALF = 128, HTB = HALF * BK * 2  , STAGE_BYTES = 8 * HTB, NXCD = 8, WGM = 8;

__host__ __device__ __forceinline__ int lds_byte(int r, int c) { const int st = (r >> 4) * 2 + (c >> 5), rr = r & 15, cc = c & 31, ob = rr * 64 + cc * 2; return st * 1024 + (ob ^ (((ob >> 9) & 1) << 5)); }
__host__ __device__ __forceinline__ void stage_rc(int b, int& R, int& C) { const int st = b / 1024, sb = b % 1024, swz = sb ^ (((sb >> 9) & 1) << 5); R = (st >> 1) * 16 + swz / 64; C = (st & 1) * 32 + (swz % 64) / 2; }
__host__ __device__ __forceinline__ int perm32(int rho) { const int n = rho >> 4, i = rho & 15; return 8 * (i >> 2) + 4 * n + (i & 3); }

struct Unit { int pm, pn; };
struct Gemm { const bf16_t* A; const bf16_t* Bt; int M, N, K; };

struct StaticOrder {
    int nM, nN, nwg, G, c;
    __host__ __device__ void init(int M, int N, int G_, int c_) { nM = M / BM; nN = N / BM; nwg = nM * nN; G = G_; c = c_; }
    __host__ __device__ bool next(int i, Unit& u) const {
        const long L = (long)i * G + c; if (L >= nwg) return false;
        int wgid = (int)L; { const int q = nwg / NXCD, r = nwg % NXCD, xcd = wgid % NXCD, off = wgid / NXCD; wgid = (xcd < r ? xcd * (q + 1) : r * (q + 1) + (xcd - r) * q) + off; }
        const int nig = WGM * nN, gid = wgid / nig, fm = gid * WGM, gsz = (nM - fm) < WGM ? (nM - fm) : WGM;
        u.pm = fm + ((wgid % nig) % gsz); u.pn = (wgid % nig) / gsz; return true;
    }
    __device__ __forceinline__ void a_ready(const Unit&) const {}
    __device__ __forceinline__ void done(const Unit&) const {}
};

typedef float f32x2 __attribute__((ext_vector_type(2)));
typedef unsigned u32x2 __attribute__((ext_vector_type(2)));
typedef __bf16 bf16v2_t __attribute__((ext_vector_type(2)));
__device__ __forceinline__ unsigned cvt_pk_bf16(float lo, float hi) { return __builtin_bit_cast(unsigned, __builtin_convertvector((f32x2){lo, hi}, bf16v2_t)); }
__device__ __forceinline__ u32x2 pack4(f32x4 v) { u32x2 w; w.x = cvt_pk_bf16(v[0], v[1]); w.y = cvt_pk_bf16(v[2], v[3]); return w; }
__device__ __forceinline__ float fast_sigmoid(float z) { return __builtin_amdgcn_rcpf(1.0f + __builtin_amdgcn_exp2f(-1.44269504089f * z)); }
constexpr float RMS_EPS = 1e-6f;

__device__ __forceinline__ float row_ss(const float* ssp, int row, int fq, int npart) {
    if (npart == 1) return ssp[row];
    const f32x4 a = *(const f32x4*)(ssp + (size_t)row * 32 + fq * 8), b = *(const f32x4*)(ssp + (size_t)row * 32 + fq * 8 + 4);
    float s = ((a[0] + a[1]) + (a[2] + a[3])) + ((b[0] + b[1]) + (b[2] + b[3])); s += __shfl_xor(s, 16); s += __shfl_xor(s, 32); return s;
}
struct EpiGateUp {
    static constexpr bool PERM = false, AFTER_DRAIN = false;
    bf16_t* H; const float* ss; int ldh; int npart;
    __device__ __forceinline__ void operator()(const f32x4 (&acc)[2][2][4][2], const Unit& u, int wr, int wc, int fr, int fq) const {
        const int row0 = u.pm * BM + wr * 64 + fr, hc0 = u.pn * 128 + wc * 16 + 4 * fq;
        float rinv8[2][4];
#pragma unroll
        for (int ai = 0; ai < 2; ++ai)
#pragma unroll
            for (int m = 0; m < 4; ++m) rinv8[ai][m] = __builtin_amdgcn_rsqf(row_ss(ss, row0 + ai * HALF + m * 16, fq, npart) * (1.0f / 2048.0f) + RMS_EPS);
#pragma unroll
        for (int ai = 0; ai < 2; ++ai)
#pragma unroll
            for (int m = 0; m < 4; ++m) { const int row = row0 + ai * HALF + m * 16; const float rinv = rinv8[ai][m];
                bf16_t* rowp = H + (size_t)row * ldh + hc0;
#pragma unroll
                for (int bj = 0; bj < 2; ++bj) { const f32x4 g = acc[ai][bj][m][0] * rinv, up = acc[ai][bj][m][1] * rinv; f32x4 hv;
#pragma unroll
                    for (int j = 0; j < 4; ++j) hv[j] = g[j] * fast_sigmoid(g[j]) * up[j];
                    *(u32x2*)(rowp + bj * 64) = pack4(hv); } }
    }
};
struct EpiResid {
    static constexpr bool PERM = false, AFTER_DRAIN = false;
    const float* basef; const bf16_t* baseb; float* outf; bf16_t* ob; float* ssacc; float scale; int ldc;
    __device__ __forceinline__ void operator()(const f32x4 (&acc)[2][2][4][2], const Unit& u, int wr, int wc, int fr, int fq) const {
        const int row0 = u.pm * BM + wr * 64 + fr, col0 = u.pn * BM + wc * 32 + 4 * fq;
#pragma unroll
        for (int ai = 0; ai < 2; ++ai)
#pragma unroll
            for (int mp = 0; mp < 2; ++mp) {
                f32x4 bs[2][2][2];
                if (basef) {
#pragma unroll
                    for (int mm = 0; mm < 2; ++mm)
#pragma unroll
                        for (int bj = 0; bj < 2; ++bj)
#pragma unroll
                            for (int n = 0; n < 2; ++n) bs[mm][bj][n] = *(const f32x4*)(basef + (size_t)(row0 + ai * HALF + (2 * mp + mm) * 16) * ldc + col0 + bj * HALF + n * 16);
                } else { u32x2 w[2][2][2];
#pragma unroll
                    for (int mm = 0; mm < 2; ++mm)
#pragma unroll
                        for (int bj = 0; bj < 2; ++bj)
#pragma unroll
                            for (int n = 0; n < 2; ++n) w[mm][bj][n] = *(const u32x2*)(baseb + (size_t)(row0 + ai * HALF + (2 * mp + mm) * 16) * ldc + col0 + bj * HALF + n * 16);
#pragma unroll
                    for (int mm = 0; mm < 2; ++mm)
#pragma unroll
                        for (int bj = 0; bj < 2; ++bj)
#pragma unroll
                            for (int n = 0; n < 2; ++n) bs[mm][bj][n] = (f32x4){__uint_as_float(w[mm][bj][n].x << 16), __uint_as_float(w[mm][bj][n].x & 0xffff0000u), __uint_as_float(w[mm][bj][n].y << 16), __uint_as_float(w[mm][bj][n].y & 0xffff0000u)};
                }
#pragma unroll
                for (int mm = 0; mm < 2; ++mm) { const int m = 2 * mp + mm, row = row0 + ai * HALF + m * 16; const size_t off = (size_t)row * ldc + col0; float s = 0.f;
#pragma unroll
                    for (int bj = 0; bj < 2; ++bj)
#pragma unroll
                        for (int n = 0; n < 2; ++n) { const f32x4 v = bs[mm][bj][n] + acc[ai][bj][m][n] * scale;
                            if (outf) *(f32x4*)(outf + off + bj * HALF + n * 16) = v;
                            if (ob) *(u32x2*)(ob + off + bj * HALF + n * 16) = pack4(v);
                            s += (v[0] * v[0] + v[1] * v[1]) + (v[2] * v[2] + v[3] * v[3]); }
                    if (ssacc) { s += __shfl_xor(s, 16); s += __shfl_xor(s, 32); if (fq == 0) ssacc[(size_t)row * 32 + u.pn * 4 + wc] = s; } }
            }
    }
};
__device__ __forceinline__ int perm_tok(int t) { return (t & ~63) | ((t & 15) << 2) | ((t >> 4) & 3); }
struct EpiWin {
    static constexpr bool PERM = false, AFTER_DRAIN = false; static constexpr size_t SEGSTRIDE = 16u * 1024u * 1024u;
    const float* ss; bf16_t* qkvu; float* ssqk;
    __device__ __forceinline__ void operator()(const f32x4 (&acc)[2][2][4][2], const Unit& u, int wr, int wc, int fr, int fq) const {
        const int seg = u.pn >> 2, ct = (u.pn & 3) * 256;
        const int row0 = u.pm * BM + wr * 64 + fr;
        float rinv[2][4];
#pragma unroll
        for (int ai = 0; ai < 2; ++ai)
#pragma unroll
            for (int m = 0; m < 4; ++m) rinv[ai][m] = __builtin_amdgcn_rsqf(row_ss(ss, row0 + ai * HALF + m * 16, fq, 32) * (1.0f / 2048.0f) + RMS_EPS);
        if (seg == 2) {
#pragma unroll
            for (int ai = 0; ai < 2; ++ai) { const int rb = u.pm * BM + ai * HALF + wr * 64; const int b = rb >> 12, tl = rb & 4095;
#pragma unroll
                for (int bj = 0; bj < 2; ++bj) { const int head = (u.pn & 3) * 2 + bj;
#pragma unroll
                    for (int n = 0; n < 2; ++n)
#pragma unroll
                        for (int j = 0; j < 4; ++j) { const int dim = wc * 32 + n * 16 + 4 * fq + j;
                            const f32x4 v = (f32x4){acc[ai][bj][0][n][j] * rinv[ai][0], acc[ai][bj][1][n][j] * rinv[ai][1], acc[ai][bj][2][n][j] * rinv[ai][2], acc[ai][bj][3][n][j] * rinv[ai][3]};
                            *(u32x2*)(qkvu + 2 * SEGSTRIDE + ((((size_t)((b * 8 + head) * 8 + (wc * 2 + n)) * 1024 + 16 * (tl >> 6) + fr) * 16 + 4 * fq + j) * 4)) = pack4(v); } } }
            return;
        }
        if (seg == 3) {
#pragma unroll
            for (int ai = 0; ai < 2; ++ai)
#pragma unroll
                for (int m = 0; m < 4; ++m) { const int row = row0 + ai * HALF + m * 16; const int b = row >> 12, t = row & 4095;
#pragma unroll
                    for (int bj = 0; bj < 2; ++bj)
#pragma unroll
                        for (int n = 0; n < 2; ++n) { const int grp = 16 * (u.pn & 3) + 8 * bj + 2 * wc + n;
                            *(u32x2*)(qkvu + 3 * SEGSTRIDE + ((size_t)(b * 64 + grp) * 4096 + t) * 16 + 4 * fq) = pack4(acc[ai][bj][m][n] * rinv[ai][m]); } }
            return;
        }
        bf16_t* dst = qkvu + (size_t)seg * SEGSTRIDE;
#pragma unroll
        for (int ai = 0; ai < 2; ++ai)
#pragma unroll
            for (int m = 0; m < 4; ++m) { const int row = row0 + ai * HALF + m * 16; bf16_t* rowp = dst + (size_t)row * 1024 + ct + wc * 32 + 4 * fq;
#pragma unroll
                for (int bj = 0; bj < 2; ++bj) { float s = 0.f;
#pragma unroll
                    for (int n = 0; n < 2; ++n) { const f32x4 v = acc[ai][bj][m][n] * rinv[ai][m]; *(u32x2*)(rowp + bj * HALF + n * 16) = pack4(v);
                        s += (v[0] * v[0] + v[1] * v[1]) + (v[2] * v[2] + v[3] * v[3]); }
                    if (seg < 2) { s += __shfl_xor(s, 16); s += __shfl_xor(s, 32);
                        if (fq == 0) ssqk[((size_t)(seg * 8 + (u.pn & 3) * 2 + bj) * 16384 + perm_tok(row)) * 4 + wc] = s; } } }
    }
};
struct EpiGlu {
    static constexpr bool PERM = false, AFTER_DRAIN = false;
    const bf16_t* yg; const float* bias; bf16_t* mixed;
    __device__ __forceinline__ void operator()(const f32x4 (&acc)[2][2][4][2], const Unit& u, int wr, int wc, int fr, int fq) const {
        const int row0 = u.pm * BM + wr * 64 + fr, col0 = u.pn * BM + wc * 32 + 4 * fq;
        f32x4 bv[2][2];
#pragma unroll
        for (int bj = 0; bj < 2; ++bj)
#pragma unroll
            for (int n = 0; n < 2; ++n) bv[bj][n] = *(const f32x4*)(bias + col0 + bj * HALF + n * 16);
#pragma unroll
        for (int ai = 0; ai < 2; ++ai) { u32x2 yw[4][2][2];
#pragma unroll
            for (int m = 0; m < 4; ++m)
#pragma unroll
                for (int bj = 0; bj < 2; ++bj)
#pragma unroll
                    for (int n = 0; n < 2; ++n) yw[m][bj][n] = *(const u32x2*)(yg + (size_t)(row0 + ai * HALF + m * 16) * 1024 + col0 + bj * HALF + n * 16);
#pragma unroll
            for (int m = 0; m < 4; ++m) { const int row = row0 + ai * HALF + m * 16;
#pragma unroll
                for (int bj = 0; bj < 2; ++bj)
#pragma unroll
                    for (int n = 0; n < 2; ++n) { const int col = col0 + bj * HALF + n * 16; const u32x2 w = yw[m][bj][n];
                        const f32x4 z = acc[ai][bj][m][n] + bv[bj][n]; f32x4 y, o;
                        y[0] = __uint_as_float(w.x << 16); y[1] = __uint_as_float(w.x & 0xffff0000u); y[2] = __uint_as_float(w.y << 16); y[3] = __uint_as_float(w.y & 0xffff0000u);
#pragma unroll
                        for (int j = 0; j < 4; ++j) o[j] = y[j] * fast_sigmoid(z[j]);
                        *(u32x2*)(mixed + (size_t)row * 2048 + 1024 + col) = pack4(o); } } }
    }
};
template <class Epi, class Sched, bool ALIGN_EPI = false, bool SP2 = false>
__device__ __forceinline__ void gemm_phase(PG8_LAS unsigned char* lds, const Gemm g, const Sched& S, const Epi& E) {
    const int tid = threadIdx.x, wid = __builtin_amdgcn_readfirstlane(tid >> 6), lane = tid & 63, wr = wid >> 2, wc = wid & 3, fr = lane & 15, fq = lane >> 4;
    const int K = g.K, nt = K / BK;
    unsigned voffA[2], voffB[2];
#pragma unroll
    for (int i = 0; i < 2; ++i) { int R, C; stage_rc(tid * 16 + i * 8192, R, C); const int Rb = Epi::PERM ? ((R & ~31) + perm32(R & 31)) : R;
        voffA[i] = (unsigned)(R * K + C) * 2u; voffB[i] = (unsigned)(Rb * K + C) * 2u; }
    const size_t kstep = (size_t)(BK * 2);
    const size_t hstep = (size_t)HALF * K * 2;
    const size_t tstep = 2 * hstep;
    const unsigned ldsw = (unsigned)wid * 1024u;
    const int aoff = lds_byte(wr * 64 + fr, fq * 8), boff = lds_byte(wc * 32 + fr, fq * 8);
#define PG8_SA(b, h) (((b) * 2 + (h)) * HTB)
#define PG8_SB(b, h) ((4 + (b) * 2 + (h)) * HTB)
#define PG8_STAGE(bufoff, gbase, voff) do { _Pragma("unroll") for (int _i = 0; _i < 2; ++_i) \
        __builtin_amdgcn_global_load_lds((const unsigned*)((const char*)(gbase) + (voff)[_i]), (PG8_LAS unsigned*)(lds + (bufoff) + ldsw + _i * 8192), 16, 0, 0); } while (0)
#define PG8_LDA(dst, b, h) do { _Pragma("unroll") for (int m = 0; m < 4; ++m) _Pragma("unroll") for (int k = 0; k < 2; ++k) dst[m][k] = *(const PG8_LAS bf16x8*)(lds + PG8_SA(b, h) + aoff + m * 2048 + k * 1024); } while (0)
#define PG8_LDB(dst, b, h) do { _Pragma("unroll") for (int n = 0; n < 2; ++n) _Pragma("unroll") for (int k = 0; k < 2; ++k) dst[n][k] = *(const PG8_LAS bf16x8*)(lds + PG8_SB(b, h) + boff + n * 2048 + k * 1024); } while (0)
#define PG8_MMA(ai, bj, At, Bt) do { __builtin_amdgcn_s_setprio(1); _Pragma("unroll") for (int m = 0; m < 4; ++m) _Pragma("unroll") for (int n = 0; n < 2; ++n) _Pragma("unroll") for (int k = 0; k < 2; ++k) \
        acc[ai][bj][m][n] = __builtin_amdgcn_mfma_f32_16x16x32_bf16(Bt[n][k], At[m][k], acc[ai][bj][m][n], 0, 0, 0); __builtin_amdgcn_s_setprio(0); } while (0)
#define PG8_WAIT_V(n) asm volatile("s_waitcnt vmcnt(" #n ")" ::: "memory")
#define PG8_WAIT_L(n) asm volatile("s_waitcnt lgkmcnt(" #n ")" ::: "memory")
#define PG8_BAR __builtin_amdgcn_s_barrier()
#define PG8_SCHED __builtin_amdgcn_sched_barrier(0)
    Unit cur, nxt; int ui = 0;
    if (!S.next(0, cur)) return;
    f32x4 acc[2][2][4][2];
#pragma unroll
    for (int a = 0; a < 2; ++a)
#pragma unroll
        for (int b = 0; b < 2; ++b)
#pragma unroll
            for (int m = 0; m < 4; ++m)
#pragma unroll
                for (int n = 0; n < 2; ++n) acc[a][b][m][n] = (f32x4){0.f, 0.f, 0.f, 0.f};
    bf16x8 At[4][2], B0[2][2], B1[2][2];
    const char* cA = (const char*)g.A + (size_t)cur.pm * tstep; const char* cB = (const char*)g.Bt + (size_t)cur.pn * tstep;
    S.a_ready(cur);
    if constexpr (SP2) {
        PG8_STAGE(PG8_SB(0, 0), cB, voffB); PG8_STAGE(PG8_SB(0, 1), cB + hstep, voffB); PG8_STAGE(PG8_SA(0, 0), cA, voffA); PG8_STAGE(PG8_SA(0, 1), cA + hstep, voffA);
        if (wr == 1) PG8_BAR;
        PG8_WAIT_V(2); PG8_BAR;
        PG8_STAGE(PG8_SB(1, 0), cB + kstep, voffB); PG8_STAGE(PG8_SA(1, 0), cA + kstep, voffA); PG8_STAGE(PG8_SB(1, 1), cB + hstep + kstep, voffB);
        PG8_WAIT_V(6); PG8_BAR;
    } else {
        PG8_STAGE(PG8_SB(0, 0), cB, voffB); PG8_STAGE(PG8_SA(0, 0), cA, voffA); PG8_STAGE(PG8_SB(0, 1), cB + hstep, voffB); PG8_STAGE(PG8_SA(0, 1), cA + hstep, voffA);
        if (wr == 1) PG8_BAR;
        PG8_WAIT_V(4); PG8_BAR;
        PG8_STAGE(PG8_SB(1, 0), cB + kstep, voffB); PG8_STAGE(PG8_SA(1, 0), cA + kstep, voffA); PG8_STAGE(PG8_SB(1, 1), cB + hstep + kstep, voffB);
        PG8_WAIT_V(6); PG8_BAR;
    }
    for (;;) {
        const bool has_next = S.next(ui + 1, nxt);
        const char* nA = has_next ? (const char*)g.A + (size_t)nxt.pm * tstep : cA; const char* nB = has_next ? (const char*)g.Bt + (size_t)nxt.pn * tstep : cB;
        for (int t = 0; t < nt; t += 2) {
            const bool last = (t == nt - 2);
            const char* a1 = cA + (size_t)(t + 1) * kstep;
            const char* a2 = last ? nA : cA + (size_t)(t + 2) * kstep; const char* b2 = last ? nB : cB + (size_t)(t + 2) * kstep;
            const char* a3 = a2 + kstep; const char* b3 = b2 + kstep;
            if (last && has_next) S.a_ready(nxt);
            if constexpr (SP2) {
            PG8_LDB(B0, 0, 0); PG8_LDB(B1, 0, 1); PG8_SCHED; PG8_LDA(At, 0, 0); PG8_STAGE(PG8_SA(1, 1), a1 + hstep, voffA);
            PG8_WAIT_V(8); PG8_WAIT_L(0); PG8_BAR; PG8_MMA(0, 0, At, B0); PG8_MMA(0, 1, At, B1); PG8_BAR; PG8_SCHED;
            PG8_LDA(At, 0, 1); PG8_STAGE(PG8_SB(0, 0), b2, voffB); PG8_STAGE(PG8_SB(0, 1), b2 + hstep, voffB); PG8_STAGE(PG8_SA(0, 0), a2, voffA);
            PG8_WAIT_V(8); PG8_WAIT_L(0); PG8_BAR; PG8_MMA(1, 0, At, B0); PG8_MMA(1, 1, At, B1); PG8_BAR; PG8_SCHED;
            PG8_LDB(B0, 1, 0); PG8_LDB(B1, 1, 1); PG8_SCHED; PG8_LDA(At, 1, 0); PG8_STAGE(PG8_SA(0, 1), a2 + hstep, voffA);
            PG8_WAIT_V(8); PG8_WAIT_L(0); PG8_BAR; PG8_MMA(0, 0, At, B0); PG8_MMA(0, 1, At, B1); PG8_BAR; PG8_SCHED;
            PG8_LDA(At, 1, 1); PG8_STAGE(PG8_SB(1, 0), b3, voffB); PG8_STAGE(PG8_SB(1, 1), b3 + hstep, voffB); PG8_STAGE(PG8_SA(1, 0), a3, voffA);
            PG8_WAIT_V(8); PG8_WAIT_L(0); PG8_BAR; PG8_MMA(1, 0, At, B0); PG8_MMA(1, 1, At, B1); PG8_BAR; PG8_SCHED;
            } else {
            PG8_LDB(B0, 0, 0); PG8_SCHED; PG8_LDA(At, 0, 0); PG8_STAGE(PG8_SA(1, 1), a1 + hstep, voffA);
            PG8_WAIT_L(8); PG8_BAR; PG8_WAIT_L(0); PG8_MMA(0, 0, At, B0); PG8_BAR; PG8_SCHED;
            PG8_LDB(B1, 0, 1); PG8_STAGE(PG8_SB(0, 0), b2, voffB);
            PG8_BAR; PG8_WAIT_L(0); PG8_MMA(0, 1, At, B1); PG8_BAR;
            PG8_LDA(At, 0, 1); PG8_STAGE(PG8_SA(0, 0), a2, voffA);
            PG8_BAR; PG8_WAIT_L(0); PG8_MMA(1, 0, At, B0); PG8_BAR; PG8_SCHED;
            PG8_STAGE(PG8_SB(0, 1), b2 + hstep, voffB);
            PG8_WAIT_V(6); PG8_BAR; PG8_MMA(1, 1, At, B1); PG8_BAR;
            PG8_LDB(B0, 1, 0); PG8_SCHED; PG8_LDA(At, 1, 0); PG8_STAGE(PG8_SA(0, 1), a2 + hstep, voffA);
            PG8_WAIT_L(8); PG8_BAR; PG8_WAIT_L(0); PG8_MMA(0, 0, At, B0); PG8_BAR; PG8_SCHED;
            PG8_LDB(B1, 1, 1); PG8_STAGE(PG8_SB(1, 0), b3, voffB);
            PG8_BAR; PG8_WAIT_L(0); PG8_MMA(0, 1, At, B1); PG8_BAR;
            PG8_LDA(At, 1, 1); PG8_STAGE(PG8_SA(1, 0), a3, voffA);
            PG8_BAR; PG8_WAIT_L(0); PG8_MMA(1, 0, At, B0); PG8_BAR; PG8_SCHED;
            PG8_STAGE(PG8_SB(1, 1), b3 + hstep, voffB);
            PG8_WAIT_V(6); PG8_BAR; PG8_MMA(1, 1, At, B1); PG8_BAR;
            }
        }
        if constexpr (ALIGN_EPI) { if (wr == 0) PG8_BAR; }
        if constexpr (!Epi::AFTER_DRAIN) { E(acc, cur, wr, wc, fr, fq); S.done(cur); }
        if (!has_next) break;
#pragma unroll
        for (int a = 0; a < 2; ++a)
#pragma unroll
            for (int b = 0; b < 2; ++b)
#pragma unroll
                for (int m = 0; m < 4; ++m)
#pragma unroll
                    for (int n = 0; n < 2; ++n) acc[a][b][m][n] = (f32x4){0.f, 0.f, 0.f, 0.f};
        cur = nxt; cA = nA; cB = nB; ++ui;
        if constexpr (ALIGN_EPI) { if (wr == 1) PG8_BAR; }
    }
    PG8_WAIT_V(0);
    if constexpr (!ALIGN_EPI) { if (wr == 0) PG8_BAR; }
    PG8_BAR;
    if constexpr (Epi::AFTER_DRAIN) { E.fused(acc, cur, wr, wc, fr, fq, lds, wid, lane); S.done(cur); }
#undef PG8_SA
#undef PG8_SB
#undef PG8_STAGE
#undef PG8_LDA
#undef PG8_LDB
#undef PG8_MMA
#undef PG8_WAIT_V
#undef PG8_WAIT_L
#undef PG8_BAR
#undef PG8_SCHED
}
}

#define LAS __attribute__((address_space(3)))
typedef unsigned short bf16_t;
typedef short bf16x8 __attribute__((ext_vector_type(8)));
typedef float f32x4 __attribute__((ext_vector_type(4)));
typedef float f32x2 __attribute__((ext_vector_type(2)));
typedef unsigned u32x4 __attribute__((ext_vector_type(4)));
typedef unsigned u32x2 __attribute__((ext_vector_type(2)));
using pg8::cvt_pk_bf16; using pg8::pack4; using pg8::perm_tok;

constexpr int M = 16384, D = 2048, FF = 5632, NIN = 4096, SEQ = 4096;
constexpr size_t MiB = 1u << 20;
constexpr size_t WS_SS0 = 402 * MiB, WS_SS1 = 403 * MiB, WS_SS2 = 405 * MiB, WS_SSQK = 407 * MiB;
constexpr size_t WS_WGU1 = 4 * MiB, WS_WD1 = 48 * MiB, WS_WIN = 70 * MiB, WS_WGLU = 86 * MiB, WS_WOUT = 88 * MiB, WS_WGU2 = 96 * MiB, WS_WD2 = 140 * MiB;
constexpr size_t WS_H2B = 4 * MiB;
constexpr size_t WS_R1 = 162 * MiB;
constexpr size_t WS_H = 226 * MiB;
constexpr size_t WS_Q = 226 * MiB, WS_K = 258 * MiB, WS_VT = 290 * MiB, WS_U = 322 * MiB, WS_YG = 354 * MiB, WS_XT = 386 * MiB;
constexpr size_t WS_BAR = 411 * MiB, WS_MIX = 412 * MiB, WS_END = 476 * MiB;
static_assert(WS_K - WS_Q == 32 * MiB && WS_VT - WS_Q == 64 * MiB && WS_U - WS_Q == 96 * MiB, "q|k|vT|u spacing");
constexpr int LDS_BYTES = 147456;

struct Params { const float* in[25]; float* out; unsigned char* ws; unsigned char bucket[3][136]; int ph_lo, ph_hi; };
#ifndef DBG_REPS
#define DBG_REPS 1
#endif
#ifndef DBG_REP4
#define DBG_REP4 1
#endif
#ifndef DBG_LAST
#define DBG_LAST 9
#define DBG_SUB 0
#define DBG_NOQ 0
#define DBG_NOK 0
#endif
#ifdef MK_SANITIZE
constexpr int NPH = 10;
#else
constexpr int NPH = 9;
#endif
#ifndef MK_N_LAUNCHES
#define MK_N_LAUNCHES 1
#endif

__device__ __forceinline__ float wave_sum(float v) {
#pragma unroll
    for (int o = 1; o < 64; o <<= 1) v += __shfl_xor(v, o);
    return v;
}
__device__ __forceinline__ float bf_lo(unsigned w) { return __uint_as_float(w << 16); }
__device__ __forceinline__ float bf_hi(unsigned w) { return __uint_as_float(w & 0xffff0000u); }

template <int MODE>
__device__ __forceinline__ void transpose_item(const float* __restrict__ W, const float* __restrict__ gain, int K, int N, bf16_t* WT, LAS float* scr, int item, int lane) {
    const int nblk = N / 32, kb = item / nblk, nb = item % nblk, k0 = 64 * kb, n0 = 32 * nb;
    float wv[32];
#pragma unroll
    for (int i = 0; i < 32; ++i) wv[i] = __builtin_nontemporal_load(W + (size_t)(k0 + 2 * i + (lane >> 5)) * N + n0 + (lane & 31));
    if (gain) {
#pragma unroll
        for (int i = 0; i < 32; ++i) wv[i] *= gain[k0 + 2 * i + (lane >> 5)]; }
#pragma unroll
    for (int i = 0; i < 32; ++i) scr[(2 * i + (lane >> 5)) * 33 + (lane & 31)] = wv[i];
    asm volatile("s_waitcnt lgkmcnt(0)" ::: "memory");
    const int c = lane & 7;
#pragma unroll
    for (int j = 0; j < 4; ++j) { const int n = (lane >> 3) + 8 * j; const LAS float* s = scr + (8 * c) * 33 + n;
        u32x4 o; o.x = cvt_pk_bf16(s[0 * 33], s[1 * 33]); o.y = cvt_pk_bf16(s[2 * 33], s[3 * 33]); o.z = cvt_pk_bf16(s[4 * 33], s[5 * 33]); o.w = cvt_pk_bf16(s[6 * 33], s[7 * 33]);
        const int ng = n0 + n; const int row = MODE == 0 ? ng : (32 * (ng >> 4) + (MODE == 2 ? 16 : 0) + (ng & 15));
        *(u32x4*)(WT + (size_t)row * K + k0 + 8 * c) = o; }
    asm volatile("s_waitcnt lgkmcnt(0)" ::: "memory");
}

__device__ __forceinline__ void sincos_d(double th, double& sn, double& cs) {
    const double k = rint(th * 0.63661977236758134308);
    double r = fma(-k, 1.57079632679489655800e+00, th); r = fma(-k, 6.12323399573676603587e-17, r);
    const long long q = (long long)k;
    const double r2 = r * r;
    double sp = -7.6471637318198164759e-13; sp = fma(sp, r2, 1.6059043836821614599e-10); sp = fma(sp, r2, -2.5052108385441718775e-08); sp = fma(sp, r2, 2.7557319223985890653e-06);
    sp = fma(sp, r2, -1.9841269841269841270e-04); sp = fma(sp, r2, 8.3333333333333333333e-03); sp = fma(sp, r2, -1.6666666666666666667e-01); const double s = fma(sp * r2, r, r);
    double cp = 4.7794773323873852974e-14; cp = fma(cp, r2, -1.1470745597729724714e-11); cp = fma(cp, r2, 2.0876756987868098979e-09); cp = fma(cp, r2, -2.7557319223985890653e-07);
    cp = fma(cp, r2, 2.4801587301587301587e-05); cp = fma(cp, r2, -1.3888888888888888889e-03); cp = fma(cp, r2, 4.1666666666666666667e-02); cp = fma(cp, r2, -0.5); const double c = fma(cp, r2, 1.0);
    const int qq = (int)(q & 3);
    sn = (qq == 0) ? s : (qq == 1) ? c : (qq == 2) ? -s : -c;
    cs = (qq == 0) ? c : (qq == 1) ? -s : (qq == 2) ? -c : s;
}
__device__ __forceinline__ double exp_d(double x) {
    const double k = rint(x * 1.44269504088896340736);
    double r = fma(-k, 6.93147180369123816490e-01, x); r = fma(-k, 1.90821492927058770002e-10, r);
    double p = 1.0 / 6227020800.0; p = fma(p, r, 1.0 / 479001600.0); p = fma(p, r, 1.0 / 39916800.0); p = fma(p, r, 1.0 / 3628800.0); p = fma(p, r, 1.0 / 362880.0); p = fma(p, r, 1.0 / 40320.0);
    p = fma(p, r, 1.0 / 5040.0); p = fma(p, r, 1.0 / 720.0); p = fma(p, r, 1.0 / 120.0); p = fma(p, r, 1.0 / 24.0); p = fma(p, r, 1.0 / 6.0); p = fma(p, r, 0.5); p = fma(p, r, 1.0); p = fma(p, r, 1.0);
    const long long e = (long long)k + 1023; const double sc = __longlong_as_double(e << 52);
    return p * sc;
}

__device__ __forceinline__ f32x2 cmul(f32x2 a, f32x2 b) { return (f32x2){a.x * b.x - a.y * b.y, a.x * b.y + a.y * b.x}; }
__device__ __forceinline__ float gelu_tanh(float x) { const float z = 0.7978845608f * (x + 0.044715f * x * x * x); return x * __builtin_amdgcn_rcpf(1.0f + __builtin_amdgcn_exp2f(-2.88539008178f * z)); }

constexpr int L_PW = 0, L_APW = 8704, L_BB = 17408, L_CC = 25600, L_KT = 33920, L_BIAS = 49152, L_MAXB = 49152 + 36864, L_RK = 90112, L_U = 42624, L_X = 42624 + 67584;
__device__ __forceinline__ void ssm_item(const Params& P, LAS unsigned char* lds, int item, int tid, int wave, int lane) {
    const int b = item >> 6, grp = item & 63;
    LAS f32x2* PW = (LAS f32x2*)(lds + L_PW); LAS f32x2* APW = (LAS f32x2*)(lds + L_APW); LAS f32x2* BB = (LAS f32x2*)(lds + L_BB); LAS f32x2* CC = (LAS f32x2*)(lds + L_CC);
    LAS bf16_t* KT = (LAS bf16_t*)(lds + L_KT);
    const bf16_t* ug = (const bf16_t*)(P.ws + WS_U); bf16_t* yg = (bf16_t*)(P.ws + WS_YG);
    float ccr[2], cci[2];
#pragma unroll
    for (int it = 0; it < 2; ++it) { ccr[it] = P.in[15][(size_t)grp * 1024 + tid + 512 * it]; cci[it] = P.in[16][(size_t)grp * 1024 + tid + 512 * it]; }
    __syncthreads();
#pragma unroll
    for (int it = 0; it < 2; ++it) { const int idx = tid + 512 * it; CC[(idx >> 6) * 65 + (idx & 63)] = (f32x2){ccr[it], cci[it]}; }
    if (tid < 64) {
        const int p = tid;
        const float lr_f = P.in[10][grp * 64 + p], li_f = P.in[11][grp * 64 + p], ldt_f = P.in[12][grp];
        f32x4 brv[4], biv[4];
#pragma unroll
        for (int c = 0; c < 4; ++c) { brv[c] = *(const f32x4*)(P.in[13] + (size_t)(grp * 64 + p) * 16 + 4 * c); biv[c] = *(const f32x4*)(P.in[14] + (size_t)(grp * 64 + p) * 16 + 4 * c); }
        __builtin_amdgcn_sched_barrier(0);
        const double lr = (double)lr_f, li = (double)li_f, dt = exp_d((double)ldt_f);
        const double mag = exp_d(lr * dt); double sn, cs; sincos_d(li * dt, sn, cs);
        const double ar = mag * cs, ai = mag * sn, zr = ar - 1.0, zi = ai, den = lr * lr + li * li;
        const double cr = (zr * lr + zi * li) / den, ci = (zi * lr - zr * li) / den;
        double pr = 1.0, pi = 0.0, alr = 1.0, ali = 0.0;
        for (int e = 0; e <= 16; ++e) { PW[e * 64 + p] = (f32x2){(float)pr, (float)pi}; if (e == 16) { alr = pr; ali = pi; } const double nr = pr * ar - pi * ai, ni = pr * ai + pi * ar; pr = nr; pi = ni; }
        pr = 1.0; pi = 0.0;
        for (int e = 0; e <= 16; ++e) { APW[e * 64 + p] = (f32x2){(float)pr, (float)pi}; const double nr = pr * alr - pi * ali, ni = pr * ali + pi * alr; pr = nr; pi = ni; }
#pragma unroll
        for (int c = 0; c < 16; ++c) { const double br = brv[c >> 2][c & 3], bi = biv[c >> 2][c & 3]; BB[p * 16 + c] = (f32x2){(float)(cr * br - ci * bi), (float)(cr * bi + ci * br)}; }
    }
    __syncthreads();
    {
        const int k = tid >> 5, co = (tid >> 1) & 15, ch = tid & 1; float acc[8];
#pragma unroll
        for (int c = 0; c < 8; ++c) acc[c] = 0.f;
        for (int p = 0; p < 64; p += 2) {
            f32x2 bb[2][8], cc[2], pw[2];
#pragma unroll
            for (int q = 0; q < 2; ++q) { cc[q] = CC[co * 65 + p + q]; pw[q] = PW[k * 64 + p + q];
#pragma unroll
                for (int c = 0; c < 8; ++c) bb[q][c] = BB[(p + q) * 16 + 8 * ch + c]; }
            __builtin_amdgcn_sched_barrier(0);
#pragma unroll
            for (int q = 0; q < 2; ++q) { const f32x2 w = cmul(cc[q], pw[q]);
#pragma unroll
                for (int c = 0; c < 8; ++c) acc[c] += w.x * bb[q][c].x - w.y * bb[q][c].y; }
        }
        const float dv = (k == 0) ? P.in[17][grp * 16 + co] : 0.f;
        unsigned pk[4];
#pragma unroll
        for (int c = 0; c < 8; c += 2) { const float v0 = acc[c] + ((8 * ch + c == co) ? dv : 0.f), v1 = acc[c + 1] + ((8 * ch + c + 1 == co) ? dv : 0.f); pk[c >> 1] = cvt_pk_bf16(v0, v1); }
        *(LAS u32x4*)(KT + (k + 1) * 256 + co * 16 + 8 * ch) = (u32x4){pk[0], pk[1], pk[2], pk[3]};
        if (tid < 128) *(LAS unsigned*)(KT + 2 * tid) = 0u;
    }
    const int n16 = lane & 15, g = lane >> 4, h8 = (g & 1) * 8;
    LAS unsigned char* UL = lds + L_U; LAS unsigned char* XL = lds + L_X;
    const int pa = 8 * wave + 2 * g, pb = pa + 1;
    const f32x2 a1a = APW[1 * 64 + pa], a2a = APW[2 * 64 + pa], a4a = APW[4 * 64 + pa], a8a = APW[8 * 64 + pa], ana = APW[(n16 + 1) * 64 + pa];
    const f32x2 a1b = APW[1 * 64 + pb], a2b = APW[2 * 64 + pb], a4b = APW[4 * 64 + pb], a8b = APW[8 * 64 + pb], anb = APW[(n16 + 1) * 64 + pb];
    f32x2 xia = (f32x2){0.f, 0.f}, xib = (f32x2){0.f, 0.f};
    const bf16_t* usrc = ug + (size_t)item * SEQ * 16;
    for (int half = 0; half < 2; ++half) {
        __syncthreads();
#pragma unroll
        for (int it = 0; it < 8; ++it) { const int e = it * 512 + tid;
            const u32x4 v = *(const u32x4*)(usrc + (size_t)half * 2048 * 16 + (size_t)e * 8);
            *(LAS u32x4*)(UL + (e >> 5) * 528 + (e & 31) * 16) = v; }
        __syncthreads();
    bf16x8 A2[8];
    {
        int opq2 = 0; asm volatile("" : "+v"(opq2)); const int pq = 16 * wave + n16, p = (pq >> 1) + opq2, cbit = pq & 1;
#pragma unroll
        for (int kp = 0; kp < 8; ++kp) { const int s = 2 * kp + (g >> 1); const f32x2 w = PW[(15 - s) * 64 + p]; unsigned pk[4];
#pragma unroll
            for (int i = 0; i < 8; i += 2) { const f32x2 b0 = BB[p * 16 + h8 + i], b1 = BB[p * 16 + h8 + i + 1];
                const float v0 = cbit ? (w.x * b0.y + w.y * b0.x) : (w.x * b0.x - w.y * b0.y), v1 = cbit ? (w.x * b1.y + w.y * b1.x) : (w.x * b1.x - w.y * b1.y);
                pk[i >> 1] = cvt_pk_bf16(v0, v1); }
            A2[kp] = __builtin_bit_cast(bf16x8, (u32x4){pk[0], pk[1], pk[2], pk[3]}); }
    }
        for (int jt = 0; jt < 8; ++jt) {
            const int jl = 16 * jt + n16;
            f32x4 Dv = (f32x4){0.f, 0.f, 0.f, 0.f}; bf16x8 uf8[8];
#pragma unroll
            for (int kp = 0; kp < 8; ++kp) uf8[kp] = *(const LAS bf16x8*)(UL + jl * 528 + (2 * kp + (g >> 1)) * 32 + (g & 1) * 16);
            __builtin_amdgcn_sched_barrier(0);
#pragma unroll
            for (int kp = 0; kp < 8; ++kp) Dv = __builtin_amdgcn_mfma_f32_16x16x32_bf16(A2[kp], uf8[kp], Dv, 0, 0, 0);
            f32x2 da = (f32x2){Dv[0], Dv[1]}, db = (f32x2){Dv[2], Dv[3]};
#define SCAN_STEP(SH, ALA, ALB) { f32x2 ta, tb; ta.x = __shfl_up(da.x, SH, 16); ta.y = __shfl_up(da.y, SH, 16); tb.x = __shfl_up(db.x, SH, 16); tb.y = __shfl_up(db.y, SH, 16); \
              if (n16 < SH) { ta = (f32x2){0.f, 0.f}; tb = (f32x2){0.f, 0.f}; } da += cmul(ALA, ta); db += cmul(ALB, tb); }
            SCAN_STEP(1, a1a, a1b) SCAN_STEP(2, a2a, a2b) SCAN_STEP(4, a4a, a4b) SCAN_STEP(8, a8a, a8b)
#undef SCAN_STEP
            da += cmul(ana, xia); db += cmul(anb, xib);
            f32x2 pa_, pb_; pa_.x = __shfl_up(da.x, 1, 16); pa_.y = __shfl_up(da.y, 1, 16); pb_.x = __shfl_up(db.x, 1, 16); pb_.y = __shfl_up(db.y, 1, 16);
            if (n16 == 0) { pa_ = xia; pb_ = xib; }
            xia.x = __shfl(da.x, 15, 16); xia.y = __shfl(da.y, 15, 16); xib.x = __shfl(db.x, 15, 16); xib.y = __shfl(db.y, 15, 16);
            u32x2 w; w.x = cvt_pk_bf16(pa_.x, pa_.y); w.y = cvt_pk_bf16(pb_.x, pb_.y);
            *(LAS u32x2*)(XL + jl * 272 + (16 * wave + 4 * g) * 2) = w;
        }
        __syncthreads();
    bf16x8 M3[2][4]; int opq3 = 0; asm volatile("" : "+v"(opq3));
#pragma unroll
    for (int ti = 0; ti < 2; ++ti) { const int t = ti ? 15 - wave : wave;
#pragma unroll
        for (int kp = 0; kp < 4; ++kp) { unsigned pk[4];
#pragma unroll
            for (int i = 0; i < 4; ++i) { const int p = 16 * kp + 4 * g + i + opq3; const f32x2 cw = cmul(CC[n16 * 65 + p], PW[(t + 1) * 64 + p]); pk[i] = cvt_pk_bf16(cw.x, -cw.y); }
            M3[ti][kp] = __builtin_bit_cast(bf16x8, (u32x4){pk[0], pk[1], pk[2], pk[3]}); } }
        for (int jt = 0; jt < 8; ++jt) {
            const int jl = 16 * jt + n16;
            int opq = 0; asm volatile("" : "+v"(opq));
            bf16x8 U[8], X[4];
#pragma unroll
            for (int kp = 0; kp < 8; ++kp) U[kp] = *(const LAS bf16x8*)(UL + jl * 528 + (2 * kp + (g >> 1)) * 32 + (g & 1) * 16);
#pragma unroll
            for (int kp = 0; kp < 4; ++kp) X[kp] = *(const LAS bf16x8*)(XL + jl * 272 + 64 * kp + 16 * g);
#pragma unroll
            for (int ti = 0; ti < 2; ++ti) { const int t = ti ? 15 - wave : wave;
                f32x4 Dv = (f32x4){0.f, 0.f, 0.f, 0.f}; bf16x8 kf8[4];
#pragma unroll
                for (int hb = 0; hb < 2; ++hb) {
#pragma unroll
                    for (int kq = 0; kq < 4; ++kq) { const int kp = 4 * hb + kq; int kk = t - (2 * kp + (g >> 1)) + 1; kk = kk < 0 ? 0 : kk; kf8[kq] = *(const LAS bf16x8*)(KT + kk * 256 + n16 * 16 + h8 + opq); }
                    __builtin_amdgcn_sched_barrier(0);
#pragma unroll
                    for (int kq = 0; kq < 4; ++kq) Dv = __builtin_amdgcn_mfma_f32_16x16x32_bf16(kf8[kq], U[4 * hb + kq], Dv, 0, 0, 0);
                    __builtin_amdgcn_sched_barrier(0); }
#pragma unroll
                for (int kp = 0; kp < 4; ++kp) Dv = __builtin_amdgcn_mfma_f32_16x16x32_bf16(M3[ti][kp], X[kp], Dv, 0, 0, 0);
                f32x4 y;
#pragma unroll
                for (int r = 0; r < 4; ++r) y[r] = gelu_tanh(Dv[r]);
                *(u32x2*)(yg + (size_t)(b * SEQ + half * 2048 + 16 * jl + t) * 1024 + 16 * grp + 4 * g) = pack4(y); }
        }
    }
}

constexpr int BIAS_PAD = 384, BIAS_OFF = 128;
typedef short bf16x4 __attribute__((ext_vector_type(4)));
struct AttnTile { bf16x8 K[4]; u32x2 V[8]; };
template <int PAT, int NQ>
__device__ __forceinline__ void attn_pat(const char* kb, const char* vb, const LAS float* rkl, const LAS float* biasp, int blk, int r16, int n16, int g, const int (&tq)[NQ], const float (&nbnd)[NQ],
                                         const bf16x8 (&Qf)[NQ][4], f32x4 (&O)[NQ][8], float (&lsum)[NQ]) {
    constexpr int SH = 2 * PAT, CSTEP = 16 >> SH, Te = PAT == 2 ? 9 : (PAT == 1 ? 12 : 24);
    const int B0 = 4 * blk;
    const int Ts = PAT == 2 ? (blk < 8 ? 8 - blk : 0) : (PAT == 1 ? (blk < 2 ? 8 - 4 * blk : 0) : (blk == 0 ? 8 : 0));
    const int um = n16 >> 2;
    const int klane = PAT == 2 ? 64 * um + 16 * (n16 & 3) + r16 : (PAT == 1 ? 16 * (n16 & 3) + (r16 & 3) + 4 * um : 16 * (n16 & 3) + um);
    const int tlane = PAT == 2 ? 64 * g + r16 : (PAT == 1 ? (r16 & 3) + 4 * g : g);
    const int ulane = PAT == 2 ? 16 * g + r16 : (PAT == 1 ? (r16 & 3) + 4 * g : g);
    const unsigned koff = (unsigned)(klane * 2048 + 16 * g), voff = (unsigned)(ulane * 128 + n16 * 8);
    const LAS float* rl = rkl + 4 * (ulane - 16 * B0 + 512);
    int dq[NQ];
#pragma unroll
    for (int q = 0; q < NQ; ++q) dq[q] = tq[q] - tlane;
    auto tokT = [&](int T) { return PAT == 2 ? 64 * (B0 - 32 + 4 * T) : (PAT == 1 ? 64 * (B0 - 8 + T) : 64 * (B0 - 2 + (T >> 2)) + 4 * (T & 3)); };
    auto unitT = [&](int T) { return PAT == 2 ? 16 * (B0 - 32 + 4 * T) : (PAT == 1 ? 16 * (B0 - 8 + T) : 16 * (B0 - 2 + (T >> 2)) + 4 * (T & 3)); };
    auto load_tile = [&](AttnTile& A, int T) __attribute__((always_inline)) {
        const char* kp_ = kb + (size_t)tokT(T) * 2048; const char* vp_ = vb + (size_t)unitT(T) * 128;
#pragma unroll
        for (int kp = 0; kp < 4; ++kp) A.K[kp] = *(const bf16x8*)(kp_ + koff + 64 * kp);
        if constexpr (NQ == 1) {
#pragma unroll
            for (int nt = 0; nt < 8; ++nt) A.V[nt] = *(const u32x2*)(vp_ + (size_t)nt * 131072 + voff); }
    };
    auto compute_tile = [&](AttnTile& A, int T) __attribute__((always_inline)) {
        if constexpr (NQ == 2) { const char* vp_ = vb + (size_t)unitT(T) * 128;
#pragma unroll
            for (int nt = 0; nt < 8; ++nt) A.V[nt] = *(const u32x2*)(vp_ + (size_t)nt * 131072 + voff); }
        const f32x4 sk = *(const LAS f32x4*)(rl + 4 * unitT(T));
#pragma unroll
        for (int q = 0; q < NQ; ++q) {
            f32x4 S = (f32x4){0.f, 0.f, 0.f, 0.f};
#pragma unroll
            for (int kp = 0; kp < 4; ++kp) S = __builtin_amdgcn_mfma_f32_16x16x32_bf16(A.K[kp], Qf[q][kp], S, 0, 0, 0);
            int d0 = (dq[q] - tokT(T)) >> SH; d0 = d0 < -80 ? -80 : (d0 > 255 ? 255 : d0);
            const LAS float* bp = biasp + d0 - 3 * CSTEP;
            float pv[4];
#pragma unroll
            for (int r = 0; r < 4; ++r) { pv[r] = __builtin_amdgcn_exp2f(S[r] * sk[r] + (bp[CSTEP * (3 - r)] + nbnd[q])); lsum[q] += pv[r]; }
            const bf16x4 Pf = __builtin_bit_cast(bf16x4, (u32x2){cvt_pk_bf16(pv[0], pv[1]), cvt_pk_bf16(pv[2], pv[3])});
#pragma unroll
            for (int nt = 0; nt < 8; ++nt) O[q][nt] = __builtin_amdgcn_mfma_f32_16x16x16bf16_1k(__builtin_bit_cast(bf16x4, A.V[nt]), Pf, O[q][nt], 0, 0, 0);
        }
    };
    AttnTile P0, P1;
    int T = Ts;
    load_tile(P0, T);
    for (;;) {
        if (T + 1 < Te) load_tile(P1, T + 1); compute_tile(P0, T); if (++T >= Te) break;
        if (T + 1 < Te) load_tile(P0, T + 1); compute_tile(P1, T); if (++T >= Te) break;
    }
}
__device__ __forceinline__ void attn_item2(const Params& P, LAS unsigned char* lds, int bhb, int wave, int lane) {
    const int blk = bhb & 15, h = (bhb >> 4) & 7, b = bhb >> 7;
    const int ra = (wave & 3) + 8 * (wave >> 2);
    asm volatile("" : "+v"(lane));
    const int n16 = lane & 15, g = lane >> 4;
    const bf16_t* qg = (const bf16_t*)(P.ws + WS_Q); const bf16_t* kg = (const bf16_t*)(P.ws + WS_K); const bf16_t* vT = (const bf16_t*)(P.ws + WS_VT);
    const float* ssqk = (const float*)(P.ws + WS_SSQK); bf16_t* mixed = (bf16_t*)(P.ws + WS_MIX);
    const LAS float* biasl = (const LAS float*)(lds + L_BIAS) + h * 3 * BIAS_PAD + BIAS_OFF;
    int tq[2]; float nbnd[2]; bf16x8 Qf[2][4];
#pragma unroll
    for (int q = 0; q < 2; ++q) {
        tq[q] = 256 * blk + ra + 4 * q + 16 * n16;
        const f32x4 qp = *(const f32x4*)(ssqk + ((size_t)h * 16384 + perm_tok(b * SEQ + tq[q])) * 4);
        const float rq = __builtin_amdgcn_rsqf(((qp[0] + qp[1]) + (qp[2] + qp[3])) * (1.0f / 128.0f) + pg8::RMS_EPS) * (1.44269504089f * 0.08838834764f);
        float ssum = 0.f;
#pragma unroll
        for (int kp = 0; kp < 4; ++kp) { const int d0 = 32 * kp + 8 * g; const u32x4 raw = *(const u32x4*)(qg + (size_t)(b * SEQ + tq[q]) * 1024 + h * 128 + d0);
            const f32x4 ga = *(const f32x4*)(P.in[7] + d0), gb = *(const f32x4*)(P.in[7] + d0 + 4), ka = *(const f32x4*)(P.in[8] + d0), kb = *(const f32x4*)(P.in[8] + d0 + 4);
            float v[8]; v[0] = bf_lo(raw.x) * ga[0] * ka[0]; v[1] = bf_hi(raw.x) * ga[1] * ka[1]; v[2] = bf_lo(raw.y) * ga[2] * ka[2]; v[3] = bf_hi(raw.y) * ga[3] * ka[3];
            v[4] = bf_lo(raw.z) * gb[0] * kb[0]; v[5] = bf_hi(raw.z) * gb[1] * kb[1]; v[6] = bf_lo(raw.w) * gb[2] * kb[2]; v[7] = bf_hi(raw.w) * gb[3] * kb[3];
#pragma unroll
            for (int i = 0; i < 8; ++i) { v[i] *= rq; ssum += v[i] * v[i]; }
            Qf[q][kp] = __builtin_bit_cast(bf16x8, (u32x4){cvt_pk_bf16(v[0], v[1]), cvt_pk_bf16(v[2], v[3]), cvt_pk_bf16(v[4], v[5]), cvt_pk_bf16(v[6], v[7])}); }
        ssum += __shfl_xor(ssum, 16); ssum += __shfl_xor(ssum, 32);
        nbnd[q] = -(11.3137085f * 1.01f * sqrtf(ssum) + *(const LAS float*)(lds + L_MAXB));
    }
    f32x4 O[2][8]; float lsum[2] = {0.f, 0.f};
#pragma unroll
    for (int q = 0; q < 2; ++q)
#pragma unroll
        for (int nt = 0; nt < 8; ++nt) O[q][nt] = (f32x4){0.f, 0.f, 0.f, 0.f};
    const char* kseq = (const char*)(kg + (size_t)(b * SEQ) * 1024 + h * 128);
    const char* vhead = (const char*)(vT + (size_t)((b * 8 + h) * 8) * 65536);
    const LAS float* rkl = (const LAS float*)(lds + L_RK);
    attn_pat<0, 2>(kseq, vhead, rkl, biasl + 0 * BIAS_PAD, blk, ra, n16, g, tq, nbnd, Qf, O, lsum);
    attn_pat<1, 2>(kseq, vhead, rkl, biasl + 1 * BIAS_PAD, blk, ra, n16, g, tq, nbnd, Qf, O, lsum);
#pragma unroll
    for (int q = 0; q < 2; ++q) {
        const int tq1[1] = {tq[q]}; const float nb1[1] = {nbnd[q]}; bf16x8 Q1[1][4]; f32x4 O1[1][8]; float l1[1] = {lsum[q]};
#pragma unroll
        for (int kp = 0; kp < 4; ++kp) Q1[0][kp] = Qf[q][kp];
#pragma unroll
        for (int nt = 0; nt < 8; ++nt) O1[0][nt] = O[q][nt];
        attn_pat<2, 1>(kseq, vhead, rkl, biasl + 2 * BIAS_PAD, blk, ra + 4 * q, n16, g, tq1, nb1, Q1, O1, l1);
#pragma unroll
        for (int nt = 0; nt < 8; ++nt) O[q][nt] = O1[0][nt];
        lsum[q] = l1[0];
    }
#pragma unroll
    for (int q = 0; q < 2; ++q) {
        float l = lsum[q]; l += __shfl_xor(l, 16); l += __shfl_xor(l, 32);
        const float inv = 1.0f / l;
        bf16_t* op = mixed + (size_t)(b * SEQ + tq[q]) * 2048 + h * 128 + 4 * g;
#pragma unroll
        for (int nt = 0; nt < 8; ++nt) *(u32x2*)(op + 16 * nt) = pack4(O[q][nt] * inv);
    }
}

#define XB_TMO      128
#define XB_XCNT(j)  (256  + 64 * (j))
#define XB_XSUB(j)  (1280 + 64 * (j))
#define XB_XGEN(j)  (2304 + 64 * (j))
#define XB_TOP      3328
#define XB_TOPGEN   3392
#define XCD_BAR_WORDS 3456
#define XB_SPIN_CAP (1u << 18)

__device__ __forceinline__ unsigned xb_ld(unsigned* p)              { return __hip_atomic_load(p, __ATOMIC_RELAXED, __HIP_MEMORY_SCOPE_AGENT); }
__device__ __forceinline__ unsigned xb_add(unsigned* p, unsigned v) { return __hip_atomic_fetch_add(p, v, __ATOMIC_RELAXED, __HIP_MEMORY_SCOPE_AGENT); }
__device__ __forceinline__ unsigned xb_xcc_id() { return (unsigned)__builtin_amdgcn_s_getreg((3 << 11) | 20) & 0xFu; }
#define XB_SPIN(cond, bar) do { unsigned _sp = 0; while (cond) { __builtin_amdgcn_s_sleep(1); \
    if ((++_sp & 255u) == 0u) { if (xb_ld(&(bar)[XB_TMO])) break; if (_sp > XB_SPIN_CAP) { atomicAdd(&(bar)[XB_TMO], 1u); break; } } } } while (0)

struct XcdBarrier {
    unsigned* bar; unsigned x;
    volatile LAS unsigned* st;
};

__device__ __forceinline__ XcdBarrier xcd_barrier_post(unsigned* bar, volatile LAS unsigned* st) {
    XcdBarrier b; b.bar = bar; b.x = xb_xcc_id(); b.st = st;
    if (threadIdx.x == 0) (void)xb_add(&bar[XB_XCNT(b.x)], 1u);
    return b;
}
__device__ __forceinline__ void xcd_barrier_complete(unsigned* bar, unsigned x, unsigned& nloc, unsigned& nx) {
    const unsigned G = gridDim.x * gridDim.y * gridDim.z;
    unsigned sum, cnt, mine, sp = 0u;
    for (;;) {
        sum = 0u; cnt = 0u; mine = 0u;
#pragma unroll
        for (unsigned j = 0; j < 16; ++j) { const unsigned c = xb_ld(&bar[XB_XCNT(j)]); sum += c; cnt += (c > 0u) ? 1u : 0u; mine = (j == x) ? c : mine; }
        if (sum == G) break;
        __builtin_amdgcn_s_sleep(1);
        if ((++sp & 255u) == 0u) { if (xb_ld(&bar[XB_TMO])) break; if (sp > XB_SPIN_CAP) { atomicAdd(&bar[XB_TMO], 1u); break; } }
    }
    nloc = mine > 0u ? mine : 1u; nx = cnt > 0u ? cnt : 1u;
}

__device__ __forceinline__ void xcd_barrier(const XcdBarrier& b) {
    asm volatile("s_waitcnt vmcnt(0)" ::: "memory");
    __syncthreads();
    if (threadIdx.x == 0) {
        unsigned* bar = b.bar;
        __builtin_amdgcn_s_waitcnt(0);
        unsigned nloc = b.st[0], nx = b.st[1];
        if (nloc == 0u) { xcd_barrier_complete(bar, b.x, nloc, nx); b.st[0] = nloc; b.st[1] = nx; }
        const unsigned old = xb_add(&bar[XB_XSUB(b.x)], 1u);
        const unsigned gen = old / nloc;
        if (old + 1u == (gen + 1u) * nloc) {
            __builtin_amdgcn_fence(__ATOMIC_RELEASE, "agent");
            asm volatile("s_waitcnt vmcnt(0)" ::: "memory");
            const unsigned og = xb_add(&bar[XB_TOP], 1u);
            const unsigned tg = og / nx;
            if (og + 1u == (tg + 1u) * nx) xb_add(&bar[XB_TOPGEN], 1u);
            else XB_SPIN(xb_ld(&bar[XB_TOPGEN]) == tg, bar);
            __builtin_amdgcn_fence(__ATOMIC_ACQUIRE, "agent");
            xb_add(&bar[XB_XGEN(b.x)], 1u);
            asm volatile("s_waitcnt vmcnt(0)" ::: "memory");
        } else {
            XB_SPIN(xb_ld(&bar[XB_XGEN(b.x)]) == gen, bar);
            __builtin_amdgcn_fence(__ATOMIC_ACQUIRE, "agent");
            asm volatile("s_waitcnt vmcnt(0)" ::: "memory");
        }
    }
    __syncthreads();
}

__global__ void __launch_bounds__(512, 2) mk_fwd(Params P) {
    extern __shared__ __attribute__((aligned(16))) unsigned char lds_raw[];
    LAS unsigned char* lds = (LAS unsigned char*)lds_raw;
    cg::grid_group grid = cg::this_grid();
    const int tid = threadIdx.x, lane = tid & 63, wave = __builtin_amdgcn_readfirstlane(tid >> 6);
    const int G = gridDim.x, bid = blockIdx.x;
    const int gw = bid * 8 + wave, NGW = G * 8;
    unsigned char* ws = P.ws;
    if (tid < 2) ((volatile LAS unsigned*)(lds + LDS_BYTES - 256))[tid] = 0u;
    __syncthreads();
    if (P.ph_lo < 0) grid.sync();
    const XcdBarrier xbar = xcd_barrier_post((unsigned*)(ws + WS_BAR), (volatile LAS unsigned*)(lds + LDS_BYTES - 256));
    float* ss0 = (float*)(ws + WS_SS0); float* ss1 = (float*)(ws + WS_SS1); float* ss2 = (float*)(ws + WS_SS2); float* ssqk = (float*)(ws + WS_SSQK);
    bf16_t* R1 = (bf16_t*)(ws + WS_R1); bf16_t* Hb = (bf16_t*)(ws + WS_H);

#define IN(k) (P.ph_lo <= (k) && (k) < P.ph_hi)
#define SYNC(k) do { if (IN(k) && IN((k) + 1)) xcd_barrier(xbar); } while (0)
    if (IN(0)) {
        for (int m = gw; m < M; m += NGW) {
            const f32x4* xr = (const f32x4*)(P.in[0] + (size_t)m * D) + lane; u32x2* orow = (u32x2*)(R1 + (size_t)m * D) + lane; float s = 0.f;
#pragma unroll
            for (int j = 0; j < 8; ++j) { const f32x4 v = xr[64 * j]; s += (v[0] * v[0] + v[1] * v[1]) + (v[2] * v[2] + v[3] * v[3]); orow[64 * j] = pack4(v); }
            s = wave_sum(s); if (lane == 0) ss0[m] = s;
        }
        LAS float* scr = (LAS float*)(lds + wave * 16384);
        constexpr int I_GU = (D / 64) * (FF / 32), I_DN = (FF / 64) * (D / 32), I_IN = (D / 64) * (NIN / 32), I_GL = (1024 / 64) * (1024 / 32), I_OUT = (D / 64) * (D / 32);
        constexpr int NITEMS = 4 * I_GU + 2 * I_DN + I_IN + I_GL + I_OUT;
        for (int it = gw; it < NITEMS; it += NGW) {
            int r = it;
            if (r < I_GU) { transpose_item<1>(P.in[2], P.in[1], D, FF, (bf16_t*)(ws + WS_WGU1), scr, r, lane); continue; } r -= I_GU;
            if (r < I_GU) { transpose_item<2>(P.in[3], P.in[1], D, FF, (bf16_t*)(ws + WS_WGU1), scr, r, lane); continue; } r -= I_GU;
            if (r < I_DN) { transpose_item<0>(P.in[4], nullptr, FF, D, (bf16_t*)(ws + WS_WD1), scr, r, lane); continue; } r -= I_DN;
            if (r < I_IN) { transpose_item<0>(P.in[6], P.in[5], D, NIN, (bf16_t*)(ws + WS_WIN), scr, r, lane); continue; } r -= I_IN;
            if (r < I_GL) { transpose_item<0>(P.in[18], nullptr, 1024, 1024, (bf16_t*)(ws + WS_WGLU), scr, r, lane); continue; } r -= I_GL;
            if (r < I_OUT) { transpose_item<0>(P.in[20], nullptr, D, D, (bf16_t*)(ws + WS_WOUT), scr, r, lane); continue; } r -= I_OUT;
            if (r < I_GU) { transpose_item<1>(P.in[22], P.in[21], D, FF, (bf16_t*)(ws + WS_WGU2), scr, r, lane); continue; } r -= I_GU;
            if (r < I_GU) { transpose_item<2>(P.in[23], P.in[21], D, FF, (bf16_t*)(ws + WS_WGU2), scr, r, lane); continue; } r -= I_GU;
            transpose_item<0>(P.in[24], nullptr, FF, D, (bf16_t*)(ws + WS_WD2), scr, r, lane);
        }
    }
    SYNC(0);
    if (IN(1)) { pg8::Gemm g{R1, (const bf16_t*)(ws + WS_WGU1), M, 2 * FF, D}; pg8::StaticOrder S; S.init(M, 2 * FF, G, bid); pg8::EpiGateUp E{Hb, ss0, FF, 1};
      pg8::gemm_phase<pg8::EpiGateUp, pg8::StaticOrder, true, true>(lds, g, S, E); }
    SYNC(1);
    if (IN(2)) { pg8::Gemm g{Hb, (const bf16_t*)(ws + WS_WD1), M, D, FF}; pg8::StaticOrder S; S.init(M, D, G, bid); pg8::EpiResid E{P.in[0], nullptr, nullptr, R1, ss1, 0.5f, D};
      pg8::gemm_phase<pg8::EpiResid, pg8::StaticOrder, true, true>(lds, g, S, E); }
    SYNC(2);
    if (IN(3)) { pg8::Gemm g{R1, (const bf16_t*)(ws + WS_WIN), M, NIN, D}; pg8::StaticOrder S; S.init(M, NIN, G, bid);
      pg8::EpiWin E{ss1, (bf16_t*)(ws + WS_Q), ssqk};
      pg8::gemm_phase<pg8::EpiWin, pg8::StaticOrder, true, true>(lds, g, S, E); }
    SYNC(3);
    for (int rep4 = 0; rep4 < DBG_REP4; ++rep4) if (IN(4)) {
        if (rep4) grid.sync();
        for (int rs = 0; rs < DBG_REPS; ++rs) for (int it = bid; it < 256; it += G) ssm_item(P, lds, it, tid, wave, lane);
        __syncthreads();
        LAS float* bl = (LAS float*)(lds + L_BIAS);
        for (int i = tid; i < 8 * 3 * BIAS_PAD; i += 512) { const int hh = i / (3 * BIAS_PAD), rem = i % (3 * BIAS_PAD), pp = rem / BIAS_PAD, dl = rem % BIAS_PAD - BIAS_OFF; bl[i] = (dl >= 0 && dl <= 128) ? P.in[9][(int)P.bucket[pp][dl] * 8 + hh] * 1.44269504089f : -1e30f; }
        if (wave == 0) { float mx = 0.f; for (int i = lane; i < 256; i += 64) mx = fmaxf(mx, fabsf(P.in[9][i]));
#pragma unroll
            for (int o = 1; o < 64; o <<= 1) mx = fmaxf(mx, __shfl_xor(mx, o));
            if (lane == 0) *(LAS float*)(lds + L_MAXB) = mx * 1.44269504089f; }
        __syncthreads();
        for (int bhb = bid; bhb < 512; bhb += G) {
            const int blk_ = bhb & 15, h_ = (bhb >> 4) & 7, b_ = bhb >> 7, Bf = 4 * blk_ - 32;
            LAS float* rkl = (LAS float*)(lds + L_RK);
            f32x4 kp4[5];
#pragma unroll
            for (int it = 0; it < 5; ++it) { int i = tid + 512 * it; i = i < 2304 ? i : 2303; int B = Bf + (i >> 6); B = B < 0 ? 0 : B;
                kp4[it] = *(const f32x4*)(ssqk + ((size_t)(8 + h_) * 16384 + b_ * SEQ + 64 * B + (i & 63)) * 4); }
#pragma unroll
            for (int it = 0; it < 5; ++it) { const int i = tid + 512 * it; const int B = Bf + (i >> 6);
                const float rv = __builtin_amdgcn_rsqf(((kp4[it][0] + kp4[it][1]) + (kp4[it][2] + kp4[it][3])) * (1.0f / 128.0f) + pg8::RMS_EPS);
                if (i < 2304) rkl[i] = B >= 0 ? rv : 0.f; }
            __syncthreads();
            attn_item2(P, lds, bhb, wave, lane);
            __syncthreads();
        }
    }
    SYNC(4);
    if (IN(5)) { pg8::Gemm g{(const bf16_t*)(ws + WS_YG), (const bf16_t*)(ws + WS_WGLU), M, 1024, 1024}; pg8::StaticOrder S; S.init(M, 1024, G, bid); pg8::EpiGlu E{(const bf16_t*)(ws + WS_YG), P.in[19], (bf16_t*)(ws + WS_MIX)};
      pg8::gemm_phase<pg8::EpiGlu, pg8::StaticOrder, true, true>(lds, g, S, E); }
    SYNC(5);
    if (IN(6)) { pg8::Gemm g{(const bf16_t*)(ws + WS_MIX), (const bf16_t*)(ws + WS_WOUT), M, D, D}; pg8::StaticOrder S; S.init(M, D, G, bid); pg8::EpiResid E{nullptr, R1, nullptr, (bf16_t*)(ws + WS_H2B), ss2, 1.0f, D};
      pg8::gemm_phase<pg8::EpiResid, pg8::StaticOrder, true, true>(lds, g, S, E); }
    SYNC(6);
    if (IN(7)) { pg8::Gemm g{(const bf16_t*)(ws + WS_H2B), (const bf16_t*)(ws + WS_WGU2), M, 2 * FF, D}; pg8::StaticOrder S; S.init(M, 2 * FF, G, bid); pg8::EpiGateUp E{Hb, ss2, FF, 32};
      pg8::gemm_phase<pg8::EpiGateUp, pg8::StaticOrder, true, true>(lds, g, S, E); }
    SYNC(7);
    if (IN(8)) { pg8::Gemm g{Hb, (const bf16_t*)(ws + WS_WD2), M, D, FF}; pg8::StaticOrder S; S.init(M, D, G, bid); pg8::EpiResid E{nullptr, (const bf16_t*)(ws + WS_H2B), P.out, nullptr, nullptr, 0.5f, D};
      pg8::gemm_phase<pg8::EpiResid, pg8::StaticOrder, true, true>(lds, g, S, E); }
#ifdef MK_SANITIZE
    SYNC(8);
    if (IN(9)) {
#if DBG_LAST == 3
        { const bf16_t* qr = (const bf16_t*)(ws + WS_Q); for (size_t i = (size_t)bid * 512 + tid; i < (size_t)M * D; i += (size_t)G * 512) P.out[i] = ssqk[i & (size_t)(1048576 - 1)]; }
#elif DBG_LAST == 4
        { const bf16_t* yr = (const bf16_t*)(ws + WS_YG); for (size_t i = (size_t)bid * 512 + tid; i < (size_t)M * D; i += (size_t)G * 512) P.out[i] = DBG_SUB == 3 ? ssqk[i & (size_t)(1048576 - 1)] : (DBG_SUB == 1 ? 0.f : __uint_as_float((unsigned)R1[i] << 16)) + (DBG_SUB == 2 ? 0.f : __uint_as_float((unsigned)yr[i & (size_t)(16777216 - 1)] << 16)); }
#endif
        for (size_t i = (size_t)bid * 512 + tid; i < (size_t)M * D; i += (size_t)G * 512) { const float v = P.out[i]; if (!(fabsf(v) < 1e30f)) P.out[i] = 0.f; } }
#endif
}

extern "C" void kernel_launch(void* const* d_in, const int* in_sizes, int n_in, void* d_out, int out_size, void* d_ws, size_t ws_size, hipStream_t stream) {
    static int grid = 0;
    if (grid == 0) {
        if (n_in != 25 || out_size != M * D || ws_size < WS_END) { fprintf(stderr, "kernel_launch: unexpected shapes (n_in %d, out %d, ws %zu)\n", n_in, out_size, ws_size); grid = -1; return; }
        int dev = 0, cus = 0, per_cu = 0;
        if (hipGetDevice(&dev) != hipSuccess || hipDeviceGetAttribute(&cus, hipDeviceAttributeMultiprocessorCount, dev) != hipSuccess) { grid = -1; return; }
        if (hipFuncSetAttribute((const void*)mk_fwd, hipFuncAttributeMaxDynamicSharedMemorySize, LDS_BYTES) != hipSuccess) { fprintf(stderr, "kernel_launch: hipFuncSetAttribute failed\n"); grid = -1; return; }
        if (hipOccupancyMaxActiveBlocksPerMultiprocessor(&per_cu, (const void*)mk_fwd, 512, LDS_BYTES) != hipSuccess || per_cu < 1) { fprintf(stderr, "kernel_launch: occupancy query says %d blocks per CU\n", per_cu); per_cu = 1; }
        (void)hipGetLastError();
        grid = cus * 1;
    }
    if (grid < 0) return;
    Params p{};
    for (int i = 0; i < 25; ++i) p.in[i] = (const float*)d_in[i];
    p.out = (float*)d_out; p.ws = (unsigned char*)d_ws;
    const int dil[3] = {1, 4, 16};
    for (int pp = 0; pp < 3; ++pp)
        for (int dl = 0; dl <= 128; ++dl) { const int dist = dl * dil[pp]; int bk;
            if (dist < 16) bk = dist; else { bk = 16 + (int)(std::log((double)dist / 16.0) / std::log(128.0) * 16.0); if (bk > 31) bk = 31; }
            p.bucket[pp][dl] = (unsigned char)bk; }
    if (hipMemsetAsync((char*)d_ws + WS_BAR, 0, 16384, stream) != hipSuccess) { fprintf(stderr, "kernel_launch: memset failed\n"); return; }
    if (MK_N_LAUNCHES == 1) {
        p.ph_lo = 0; p.ph_hi = NPH;
        void* args[] = {&p};
        const hipError_t e = hipLaunchCooperativeKernel((const void*)mk_fwd, dim3(grid), dim3(512), args, LDS_BYTES, stream);
        if (e != hipSuccess) fprintf(stderr, "kernel_launch: cooperative launch failed: %s (grid %d)\n", hipGetErrorString(e), grid);
    } else {
        for (int k = 0; k < NPH; ++k) { if (k > DBG_LAST && k != 9) continue; p.ph_lo = k; p.ph_hi = k + 1; hipLaunchKernelGGL(mk_fwd, dim3(grid), dim3(512), LDS_BYTES, stream, p); }
    }
}
```
